# Optimizing an MI355X kernel written in HIP

```python
import math
import jax, jax.numpy as jnp
from jax import lax
import numpy as np

D_MODEL = 1024
BATCH = 4
SEQ = 8192
DEPTH = 4

HEAD_DIM = 64
N_BRANCH = 4
BRANCH_WIDTH = D_MODEL // N_BRANCH
POOL_WINDOWS = (2, 4, 8, 16)
N_POOL_GROUPS = len(POOL_WINDOWS)
POOL_GROUP = BRANCH_WIDTH // N_POOL_GROUPS
CONV_K = 3
MOBA_HEADS = BRANCH_WIDTH // HEAD_DIM
MOBA_BLOCK = 256
MOBA_TOPK = 3
MOBA_Q_CHUNK = 64
FOX_HEADS = BRANCH_WIDTH // HEAD_DIM
FOX_Q_BLOCK = 128
D_FF = 4 * D_MODEL
ROPE_THETA = 500000.0
ROPE_DIM = HEAD_DIM // 4
ALPHA = (2 * DEPTH) ** 0.25
BETA = (8 * DEPTH) ** -0.25
LN_EPS = 1e-5
FORGET_BIAS_INIT = 2.0
IN_SPLIT_WIDTHS = (BRANCH_WIDTH,) * 10 + (FOX_HEADS, N_BRANCH * D_MODEL)
IN_WIDTH = 10 * BRANCH_WIDTH + FOX_HEADS + N_BRANCH * D_MODEL
FORGET_COL0 = 10 * BRANCH_WIDTH

kernel_name = "hybrid_parallel_pool_conv_moba_fox_block"


def _in_split_points():
    pts, acc = [], 0
    for w in IN_SPLIT_WIDTHS[:-1]:
        acc += w
        pts.append(acc)
    return pts


def layer_norm(x):
    xf = x.astype(jnp.float32)
    mu = jnp.mean(xf, axis=-1, keepdims=True)
    var = jnp.mean(jnp.square(xf - mu), axis=-1, keepdims=True)
    return ((xf - mu) * lax.rsqrt(var + LN_EPS)).astype(x.dtype)


def rotary_tables(positions):
    inv = ROPE_THETA ** (-jnp.arange(0, ROPE_DIM, 2, dtype=jnp.float32) / ROPE_DIM)
    ang = positions.astype(jnp.float32)[..., None] * inv
    return jnp.cos(ang)[:, None], jnp.sin(ang)[:, None]


def apply_partial_rotary(t, cos, sin):
    half = ROPE_DIM // 2
    t1, t2, rest = t[..., :half], t[..., half:ROPE_DIM], t[..., ROPE_DIM:]
    r1 = (t1 * cos - t2 * sin).astype(t.dtype)
    r2 = (t2 * cos + t1 * sin).astype(t.dtype)
    return jnp.concatenate([r1, r2, rest], axis=-1)


def to_heads(t, n_heads):
    b, s, _ = t.shape
    return t.reshape(b, s, n_heads, HEAD_DIM).transpose(0, 2, 1, 3)


def from_heads(t):
    b, h, s, d = t.shape
    return t.transpose(0, 2, 1, 3).reshape(b, s, h * d)


def pool_mixer(p, w_pool, pool_scale):
    s = p.shape[1]
    t = jnp.arange(s)
    groups = jnp.split(p, N_POOL_GROUPS, axis=-1)
    outs = []
    for g, w in zip(groups, POOL_WINDOWS):
        cs = jnp.cumsum(g.astype(jnp.float32), axis=1)
        cs_prev = jnp.pad(cs, ((0, 0), (w, 0), (0, 0)))[:, :s]
        cnt = jnp.minimum(t + 1, w).astype(jnp.float32)[None, :, None]
        outs.append(((cs - cs_prev) / cnt).astype(p.dtype) - g)
    pooled = jnp.stack(outs, axis=2)
    mixed = jnp.einsum('bsgc,gcd->bsgd', pooled, w_pool)
    return mixed.reshape(p.shape) * pool_scale


def short_conv_mixer(gate_b, gate_c, h, conv_w):
    v = gate_c * h
    z = lax.conv_general_dilated(
        v, conv_w[:, None, :], window_strides=(1,), padding=[(CONV_K - 1, 0)],
        dimension_numbers=('NWC', 'WIO', 'NWC'), feature_group_count=v.shape[-1])
    return gate_b * z


def moba_attention(q, k, v):
    b, h, s, hd = q.shape
    nblk = -(-s // MOBA_BLOCK)
    s_pad = nblk * MOBA_BLOCK
    pad = ((0, 0), (0, 0), (0, s_pad - s), (0, 0))
    kb = jnp.pad(k, pad).reshape(b, h, nblk, MOBA_BLOCK, hd)
    vb = jnp.pad(v, pad).reshape(b, h, nblk, MOBA_BLOCK, hd)
    kbar = jnp.mean(kb.astype(jnp.float32), axis=3)
    n_sel = min(MOBA_TOPK, nblk)
    scale = HEAD_DIM ** -0.5
    bi = jnp.arange(b)[:, None, None, None]
    hi = jnp.arange(h)[None, :, None, None]
    blk_ids = jnp.arange(nblk)
    n_chunks = s // MOBA_Q_CHUNK

    def chunk(ci):
        t0 = ci * MOBA_Q_CHUNK
        qc = lax.dynamic_slice_in_dim(q, t0, MOBA_Q_CHUNK, axis=2)
        tq = t0 + jnp.arange(MOBA_Q_CHUNK)
        own = t0 // MOBA_BLOCK
        score = jnp.einsum('bhqd,bhnd->bhqn', qc.astype(jnp.float32), kbar)
        score = jnp.where(blk_ids < own, score, -jnp.inf)
        _, idx = lax.top_k(score, n_sel)
        sel_valid = idx < own
        k_sel = kb[bi, hi, idx]
        v_sel = vb[bi, hi, idx]
        l_sel = jnp.einsum('bhqd,bhqkld->bhqkl', qc, k_sel).astype(jnp.float32) * scale
        l_sel = jnp.where(sel_valid[..., None], l_sel, -jnp.inf)
        k_own = lax.dynamic_index_in_dim(kb, own, axis=2, keepdims=False)
        v_own = lax.dynamic_index_in_dim(vb, own, axis=2, keepdims=False)
        l_own = jnp.einsum('bhqd,bhld->bhql', qc, k_own).astype(jnp.float32) * scale
        pos_own = own * MOBA_BLOCK + jnp.arange(MOBA_BLOCK)
        l_own = jnp.where(pos_own[None, :] <= tq[:, None], l_own, -jnp.inf)
        n_k = n_sel * MOBA_BLOCK
        logits = jnp.concatenate([l_sel.reshape(b, h, MOBA_Q_CHUNK, n_k), l_own], axis=-1)
        p = jax.nn.softmax(logits, axis=-1)
        p_sel = p[..., :n_k].reshape(b, h, MOBA_Q_CHUNK, n_sel, MOBA_BLOCK).astype(v.dtype)
        p_own = p[..., n_k:].astype(v.dtype)
        return (jnp.einsum('bhqkl,bhqkld->bhqd', p_sel, v_sel)
                + jnp.einsum('bhql,bhld->bhqd', p_own, v_own))

    out = lax.map(chunk, jnp.arange(n_chunks))
    return out.transpose(1, 2, 0, 3, 4).reshape(b, h, s, hd)


def forgetting_attention(q, k, v, log_f):
    b, h, s, hd = q.shape
    cum = jnp.cumsum(log_f, axis=-1)
    scale = HEAD_DIM ** -0.5
    s_pos = jnp.arange(s)

    def block(qi):
        t0 = qi * FOX_Q_BLOCK
        qb = lax.dynamic_slice_in_dim(q, t0, FOX_Q_BLOCK, axis=2)
        cq = lax.dynamic_slice_in_dim(cum, t0, FOX_Q_BLOCK, axis=2)
        tq = t0 + jnp.arange(FOX_Q_BLOCK)
        logits = (jnp.einsum('bhqd,bhkd->bhqk', qb, k).astype(jnp.float32) * scale
                  + cq[..., :, None] - cum[..., None, :])
        logits = jnp.where(s_pos[None, :] <= tq[:, None], logits, -jnp.inf)
        p = jax.nn.softmax(logits, axis=-1)
        return jnp.einsum('bhqk,bhkd->bhqd', p.astype(v.dtype), v)

    out = lax.map(block, jnp.arange(s // FOX_Q_BLOCK))
    return out.transpose(1, 2, 0, 3, 4).reshape(b, h, s, hd)


def hybrid_layer(x, cond_act, cos, sin, w_ada, b_ada, w_in, b_in, w_pool, pool_scale, conv_w,
                 w_branch, w_o, ln1_g, ln1_b, w_up, b_up, w_down, ln2_g, ln2_b):
    ada = (cond_act @ w_ada + b_ada)[:, None, :]
    sh1, sc1, g1, sh2, sc2, g2 = jnp.split(ada, 6, axis=-1)

    u = layer_norm(x) * (1 + sc1) + sh1
    proj = u @ w_in + b_in
    (p_in, c_b, c_c, c_h, mq, mk, mv, fq, fk, fv, f_logit, gate_logit) = jnp.split(
        proj, _in_split_points(), axis=-1)

    y_pool = pool_mixer(p_in, w_pool, pool_scale)
    y_conv = short_conv_mixer(c_b, c_c, c_h, conv_w)
    q_m = apply_partial_rotary(to_heads(mq, MOBA_HEADS), cos, sin)
    k_m = apply_partial_rotary(to_heads(mk, MOBA_HEADS), cos, sin)
    y_moba = from_heads(moba_attention(q_m, k_m, to_heads(mv, MOBA_HEADS)))
    log_f = jax.nn.log_sigmoid(f_logit.astype(jnp.float32)).transpose(0, 2, 1)
    y_fox = from_heads(forgetting_attention(to_heads(fq, FOX_HEADS), to_heads(fk, FOX_HEADS),
                                            to_heads(fv, FOX_HEADS), log_f))

    gates = jax.nn.sigmoid(gate_logit)
    branches = (y_pool, y_conv, y_moba, y_fox)
    merged = None
    for n in range(N_BRANCH):
        term = gates[..., n * D_MODEL:(n + 1) * D_MODEL] * (branches[n] @ w_branch[n])
        merged = term if merged is None else merged + term
    mixed = merged @ w_o
    x = layer_norm(ALPHA * x + g1 * mixed) * ln1_g + ln1_b

    u2 = layer_norm(x) * (1 + sc2) + sh2
    hdn = jnp.square(jax.nn.relu(u2 @ w_up + b_up))
    x = layer_norm(ALPHA * x + g2 * (hdn @ w_down)) * ln2_g + ln2_b
    return x


def setup_inputs(seed: int = 0) -> dict:
    key = jax.random.key(seed)
    ks = jax.random.split(key, 24)
    f32 = jnp.float32
    nrm = lambda k, shape, s: jax.random.normal(k, shape, f32) * s
    x = jax.random.normal(ks[0], (BATCH, SEQ, D_MODEL), f32)
    c = jax.random.normal(ks[1], (BATCH, D_MODEL), f32)
    offsets = jax.random.randint(ks[2], (BATCH, 1), 0, 1024, dtype=jnp.int32)
    positions = jnp.arange(SEQ, dtype=jnp.int32)[None, :] + offsets
    w_ada = nrm(ks[3], (DEPTH, D_MODEL, 6 * D_MODEL), D_MODEL ** -0.5)
    b_ada = nrm(ks[4], (DEPTH, 6 * D_MODEL), 0.01)
    w_in = nrm(ks[5], (DEPTH, D_MODEL, IN_WIDTH), D_MODEL ** -0.5)
    b_in_raw = nrm(ks[6], (DEPTH, IN_WIDTH), 0.01)
    forget_b = FORGET_BIAS_INIT + nrm(ks[7], (DEPTH, FOX_HEADS), 0.1)
    b_in = jnp.concatenate([b_in_raw[:, :FORGET_COL0], forget_b,
                            b_in_raw[:, FORGET_COL0 + FOX_HEADS:]], axis=-1)
    w_pool = nrm(ks[8], (DEPTH, N_POOL_GROUPS, POOL_GROUP, POOL_GROUP), POOL_GROUP ** -0.5)
    pool_scale = 1.0 + nrm(ks[9], (DEPTH, BRANCH_WIDTH), 0.02)
    conv_w = nrm(ks[10], (DEPTH, CONV_K, BRANCH_WIDTH), CONV_K ** -0.5)
    w_branch = nrm(ks[11], (DEPTH, N_BRANCH, BRANCH_WIDTH, D_MODEL), BRANCH_WIDTH ** -0.5)
    w_o = nrm(ks[12], (DEPTH, D_MODEL, D_MODEL), BETA * D_MODEL ** -0.5)
    ln1_g = 1.0 + nrm(ks[13], (DEPTH, D_MODEL), 0.02)
    ln1_b = nrm(ks[14], (DEPTH, D_MODEL), 0.02)
    w_up = nrm(ks[15], (DEPTH, D_MODEL, D_FF), D_MODEL ** -0.5)
    b_up = nrm(ks[16], (DEPTH, D_FF), 0.01)
    w_down = nrm(ks[17], (DEPTH, D_FF, D_MODEL), BETA * D_FF ** -0.5)
    ln2_g = 1.0 + nrm(ks[18], (DEPTH, D_MODEL), 0.02)
    ln2_b = nrm(ks[19], (DEPTH, D_MODEL), 0.02)
    return {"x": x, "c": c, "positions": positions, "w_ada": w_ada, "b_ada": b_ada,
            "w_in": w_in, "b_in": b_in, "w_pool": w_pool, "pool_scale": pool_scale,
            "conv_w": conv_w, "w_branch": w_branch, "w_o": w_o, "ln1_g": ln1_g, "ln1_b": ln1_b,
            "w_up": w_up, "b_up": b_up, "w_down": w_down, "ln2_g": ln2_g, "ln2_b": ln2_b}


def reference(x, c, positions, w_ada, b_ada, w_in, b_in, w_pool, pool_scale, conv_w, w_branch,
              w_o, ln1_g, ln1_b, w_up, b_up, w_down, ln2_g, ln2_b):
    cos, sin = rotary_tables(positions)
    cond_act = jax.nn.silu(c)
    for l in range(DEPTH):
        x = hybrid_layer(x, cond_act, cos, sin, w_ada[l], b_ada[l], w_in[l], b_in[l], w_pool[l],
                         pool_scale[l], conv_w[l], w_branch[l], w_o[l], ln1_g[l], ln1_b[l],
                         w_up[l], b_up[l], w_down[l], ln2_g[l], ln2_b[l])
    return x
```

```cpp
#include <hip/hip_runtime.h>
#include <hip/hip_cooperative_groups.h>
#include <hip/hip_bf16.h>
#include <cstdio>
#include <cstdint>
#include <cmath>
#include <type_traits>
namespace cg = cooperative_groups;
namespace pg8 {
#define PG8_LAS __attribute__((address_space(3)))
typedef unsigned short bf16_t;
typedef short bf16x8 __attribute__((ext_vector_type(8)));
typedef float f32x4 __attribute__((ext_vector_type(4)));
typedef unsigned u32x4 __attribute__((ext_vector_type(4)));
constexpr int BM = 256, BK = 64, HALF = 128, HTB = HALF * BK * 2  , STAGE_BYTES = 8 * HTB, NXCD = 8, WGM = 8;

__host__ __device__ __forceinline__ int lds_byte(int r, int c) { const int st = (r >> 4) * 2 + (c >> 5), rr = r & 15, cc = c & 31, ob = rr * 64 + cc * 2; return st * 1024 + (ob ^ (((ob >> 9) & 1) << 5)); }
__host__ __device__ __forceinline__ void stage_rc(int b, int& R, int& C) { const int st = b / 1024, sb = b % 1024, swz = sb ^ (((sb >> 9) & 1) << 5); R = (st >> 1) * 16 + swz / 64; C = (st & 1) * 32 + (swz % 64) / 2; }
__host__ __device__ __forceinline__ int perm32(int rho) { const int n = rho >> 4, i = rho & 15; return 8 * (i >> 2) + 4 * n + (i & 3); }

struct Unit { int pm, pn; };
struct Gemm { const bf16_t* A; const bf16_t* Bt; int M, N, K; };

struct StaticOrder {
    int nM, nN, nwg, G, c;
    __host__ __device__ void init(int M, int N, int G_, int c_) { nM = M / BM; nN = N / BM; nwg = nM * nN; G = G_; c = c_; }
    __host__ __device__ bool next(int i, Unit& u) const {
        const long L = (long)i * G + c; if (L >= nwg) return false;
        int wgid = (int)L; { const int q = nwg / NXCD, r = nwg % NXCD, xcd = wgid % NXCD, off = wgid / NXCD; wgid = (xcd < r ? xcd * (q + 1) : r * (q + 1) + (xcd - r) * q) + off; }
        const int nig = WGM * nN, gid = wgid / nig, fm = gid * WGM, gsz = (nM - fm) < WGM ? (nM - fm) : WGM;
        u.pm = fm + ((wgid % nig) % gsz); u.pn = (wgid % nig) / gsz; return true;
    }
    __device__ __forceinline__ void a_ready(const Unit&) const {}
    __device__ __forceinline__ void done(const Unit&) const {}
};

typedef float f32x2c_t __attribute__((ext_vector_type(2))); typedef __bf16 bf16x2c_t __attribute__((ext_vector_type(2)));
__device__ __forceinline__ unsigned cvt_pk_bf16(float lo, float hi) { f32x2c_t v = {lo, hi}; bf16x2c_t b = __builtin_convertvector(v, bf16x2c_t); return __builtin_bit_cast(unsigned, b); }
typedef float f32x2 __attribute__((ext_vector_type(2)));
__device__ __forceinline__ float bf_lo(unsigned w) { return __uint_as_float(w << 16); }
__device__ __forceinline__ float bf_hi(unsigned w) { return __uint_as_float(w & 0xffff0000u); }
template <int ACT> struct EpiAct {
    static constexpr bool PERM = true, AFTER_DRAIN = false;
    bf16_t* O; int ldc; const float* bias; int split_cols; size_t split_stride; int qs0, qs1; float qscale;
    __device__ __forceinline__ float act(float v) const {
        if (ACT == 1) return __builtin_amdgcn_rcpf(1.0f + __builtin_amdgcn_exp2f(-1.4426950408889634f * v));
        if (ACT == 2) { const float r = v > 0.f ? v : 0.f; return r * r; }
        return v;
    }
    __device__ __forceinline__ void operator()(const f32x4 (&acc)[2][2][4][2], const Unit& u, int wr, int wc, int fr, int fq) const {
        const int row0 = u.pm * BM + wr * 64 + fr; int colt = u.pn * BM; bf16_t* base = O;
        if (split_cols) { const int t = colt / split_cols; base += (size_t)t * split_stride; colt -= t * split_cols; }
        const float sc = (u.pn == qs0 || u.pn == qs1) ? qscale : 1.f;
        const int col0 = colt + wc * 32 + 8 * fq, bcol0 = u.pn * BM + wc * 32 + 8 * fq;
        f32x4 bv[2][2];
#pragma unroll
        for (int bj = 0; bj < 2; ++bj)
#pragma unroll
            for (int n = 0; n < 2; ++n) bv[bj][n] = bias ? *(const f32x4*)(bias + bcol0 + bj * HALF + 4 * n) : (f32x4){0.f, 0.f, 0.f, 0.f};
#pragma unroll
        for (int ai = 0; ai < 2; ++ai)
#pragma unroll
            for (int m = 0; m < 4; ++m) { bf16_t* rowp = base + (size_t)(row0 + ai * HALF + m * 16) * ldc + col0;
#pragma unroll
                for (int bj = 0; bj < 2; ++bj) { f32x4 v0 = acc[ai][bj][m][0] + bv[bj][0], v1 = acc[ai][bj][m][1] + bv[bj][1];
                    if (ACT != 0) { v0 = (f32x4){act(v0[0]), act(v0[1]), act(v0[2]), act(v0[3])}; v1 = (f32x4){act(v1[0]), act(v1[1]), act(v1[2]), act(v1[3])}; }
                    v0 = v0 * sc; v1 = v1 * sc; u32x4 w; w.x = cvt_pk_bf16(v0[0], v0[1]); w.y = cvt_pk_bf16(v0[2], v0[3]); w.z = cvt_pk_bf16(v1[0], v1[1]); w.w = cvt_pk_bf16(v1[2], v1[3]);
                    *(u32x4*)(rowp + bj * HALF) = w; } }
    }
};
struct EpiGate8 {
    static constexpr bool PERM = true, AFTER_DRAIN = false;
    unsigned char* O; const float* bias; float pre;
    __device__ __forceinline__ unsigned q8(float v) const { const float s = __builtin_amdgcn_rcpf(1.0f + __builtin_amdgcn_exp2f(-1.4426950408889634f * v)); return (unsigned)(s * 255.0f + 0.5f); }
    __device__ __forceinline__ void operator()(const f32x4 (&acc)[2][2][4][2], const Unit& u, int wr, int wc, int fr, int fq) const {
        const int row0 = u.pm * BM + wr * 64 + fr; const int colt = u.pn * BM; const int t = colt >> 10;
        unsigned char* base = O + (size_t)t * ((size_t)32768 * 1024);
        const int col0 = (colt & 1023) + wc * 32 + 8 * fq, bcol0 = colt + wc * 32 + 8 * fq;
        f32x4 bv[2][2];
#pragma unroll
        for (int bj = 0; bj < 2; ++bj)
#pragma unroll
            for (int n = 0; n < 2; ++n) bv[bj][n] = *(const f32x4*)(bias + bcol0 + bj * HALF + 4 * n);
#pragma unroll
        for (int ai = 0; ai < 2; ++ai)
#pragma unroll
            for (int m = 0; m < 4; ++m) { unsigned char* rowp = base + (size_t)(row0 + ai * HALF + m * 16) * 1024 + col0;
#pragma unroll
                for (int bj = 0; bj < 2; ++bj) { const f32x4 v0 = acc[ai][bj][m][0] * pre + bv[bj][0], v1 = acc[ai][bj][m][1] * pre + bv[bj][1];
                    typedef unsigned u32x2 __attribute__((ext_vector_type(2))); u32x2 w;
                    w.x = q8(v0[0]) | (q8(v0[1]) << 8) | (q8(v0[2]) << 16) | (q8(v0[3]) << 24); w.y = q8(v1[0]) | (q8(v1[1]) << 8) | (q8(v1[2]) << 16) | (q8(v1[3]) << 24);
                    *(u32x2*)(rowp + bj * HALF) = w; }
                asm volatile("" ::: "memory"); }
    }
};
template <bool XF32> struct EpiRes {
    static constexpr bool PERM = true, AFTER_DRAIN = false;
    static constexpr int gate_bstride = 6 * 1024, NROWS = 32768; static constexpr float alpha = 1.681792830507429f;
    const void* xin; bf16_t* yout; const float* gate; const float* stats;
    __device__ __forceinline__ void operator()(const f32x4 (&acc)[2][2][4][2], const Unit& u, int wr, int wc, int fr, int fq) const {
        const int row0 = u.pm * BM + wr * 64 + fr, col0 = u.pn * BM + wc * 32 + 8 * fq; const int b = (u.pm * BM) >> 13;
        const float* gp = gate + (size_t)b * gate_bstride + col0;
        f32x4 gv[2][2], lg[2][2], lb[2][2];
#pragma unroll
        for (int bj = 0; bj < 2; ++bj)
#pragma unroll
            for (int n = 0; n < 2; ++n) { gv[bj][n] = *(const f32x4*)(gp + bj * HALF + 4 * n);
                if (!XF32) { lg[bj][n] = *(const f32x4*)(stats + 2 * NROWS + col0 + bj * HALF + 4 * n); lb[bj][n] = *(const f32x4*)(stats + 2 * NROWS + 1024 + col0 + bj * HALF + 4 * n); } }
#pragma unroll
        for (int ai = 0; ai < 2; ++ai)
#pragma unroll
            for (int mh = 0; mh < 2; ++mh) {
                f32x4 xv[2][2][2]; f32x2 st[2];
#pragma unroll
                for (int mm = 0; mm < 2; ++mm) { const int r = row0 + ai * HALF + (2 * mh + mm) * 16; const size_t off = (size_t)r * 1024 + col0;
                    if (XF32) { st[mm] = (f32x2){0.f, 0.f};
#pragma unroll
                        for (int bj = 0; bj < 2; ++bj)
#pragma unroll
                            for (int n = 0; n < 2; ++n) xv[mm][bj][n] = *(const f32x4*)((const float*)xin + off + bj * HALF + 4 * n);
                    } else { st[mm] = *(const f32x2*)(stats + 2 * (size_t)r);
#pragma unroll
                        for (int bj = 0; bj < 2; ++bj) { const u32x4 yw = *(const u32x4*)((const bf16_t*)xin + off + bj * HALF);
                            xv[mm][bj][0] = (f32x4){bf_lo(yw.x), bf_hi(yw.x), bf_lo(yw.y), bf_hi(yw.y)}; xv[mm][bj][1] = (f32x4){bf_lo(yw.z), bf_hi(yw.z), bf_lo(yw.w), bf_hi(yw.w)}; } } }
                asm volatile("" ::: "memory");
#pragma unroll
                for (int mm = 0; mm < 2; ++mm) { const int m = 2 * mh + mm; const size_t off = (size_t)(row0 + ai * HALF + m * 16) * 1024 + col0;
#pragma unroll
                    for (int bj = 0; bj < 2; ++bj) { f32x4 o[2];
#pragma unroll
                        for (int n = 0; n < 2; ++n) { f32x4 xa;
                            if (!XF32) xa = (xv[mm][bj][n] - st[mm].x) * st[mm].y * lg[bj][n] + lb[bj][n];
                            else xa = xv[mm][bj][n] * alpha;
                            o[n] = xa + gv[bj][n] * acc[ai][bj][m][n]; }
                        u32x4 w; w.x = cvt_pk_bf16(o[0][0], o[0][1]); w.y = cvt_pk_bf16(o[0][2], o[0][3]); w.z = cvt_pk_bf16(o[1][0], o[1][1]); w.w = cvt_pk_bf16(o[1][2], o[1][3]);
                        *(u32x4*)(yout + off + bj * HALF) = w; } }
                asm volatile("" ::: "memory"); }
    }
};
struct EpiMerge {
    static constexpr bool PERM = true, AFTER_DRAIN = false;
    const bf16_t* G; float* macc; bf16_t* Mout; int mode;
    __device__ __forceinline__ void operator()(const f32x4 (&acc)[2][2][4][2], const Unit& u, int wr, int wc, int fr, int fq) const {
        const int row0 = u.pm * BM + wr * 64 + fr, col0 = u.pn * BM + wc * 32 + 8 * fq;
#pragma unroll
        for (int ai = 0; ai < 2; ++ai)
#pragma unroll
            for (int m = 0; m < 4; ++m) { const size_t off = (size_t)(row0 + ai * HALF + m * 16) * 1024 + col0;
#pragma unroll
                for (int bj = 0; bj < 2; ++bj) { const u32x4 gw = *(const u32x4*)(G + off + bj * HALF);
                    f32x4 v0 = acc[ai][bj][m][0] * (f32x4){bf_lo(gw.x), bf_hi(gw.x), bf_lo(gw.y), bf_hi(gw.y)};
                    f32x4 v1 = acc[ai][bj][m][1] * (f32x4){bf_lo(gw.z), bf_hi(gw.z), bf_lo(gw.w), bf_hi(gw.w)};
                    if (mode != 0) { v0 += *(const f32x4*)(macc + off + bj * HALF); v1 += *(const f32x4*)(macc + off + bj * HALF + 4); }
                    if (mode != 2) { *(f32x4*)(macc + off + bj * HALF) = v0; *(f32x4*)(macc + off + bj * HALF + 4) = v1; }
                    else { u32x4 w; w.x = cvt_pk_bf16(v0[0], v0[1]); w.y = cvt_pk_bf16(v0[2], v0[3]); w.z = cvt_pk_bf16(v1[0], v1[1]); w.w = cvt_pk_bf16(v1[2], v1[3]); *(u32x4*)(Mout + off + bj * HALF) = w; } }
                asm volatile("" ::: "memory"); }
    }
};

template <class Epi, class Sched, bool ALIGN_EPI = false, bool SP2 = false>
__device__ __forceinline__ void gemm_phase(PG8_LAS unsigned char* lds, const Gemm g, const Sched& S, const Epi& E) {
    int tid_ = threadIdx.x; asm volatile("" : "+v"(tid_)); tid_ &= 511;
    const int tid = tid_, wid = __builtin_amdgcn_readfirstlane(tid >> 6), lane = tid & 63, wr = wid >> 2, wc = wid & 3, fr = lane & 15, fq = lane >> 4;
    const int K = g.K, nt = K / BK;
    unsigned voffA[2], voffB[2];
#pragma unroll
    for (int i = 0; i < 2; ++i) { int R, C; stage_rc(tid * 16 + i * 8192, R, C); const int Rb = Epi::PERM ? ((R & ~31) + perm32(R & 31)) : R;
        voffA[i] = (unsigned)(R * K + C) * 2u; voffB[i] = (unsigned)(Rb * K + C) * 2u; }
    const size_t kstep = (size_t)(BK * 2);
    const size_t hstep = (size_t)HALF * K * 2;
    const size_t tstep = 2 * hstep;
    const unsigned ldsw = (unsigned)wid * 1024u;
    const int aoff = lds_byte(wr * 64 + fr, fq * 8), boff = lds_byte(wc * 32 + fr, fq * 8);
#define PG8_SA(b, h) (((b) * 2 + (h)) * HTB)
#define PG8_SB(b, h) ((4 + (b) * 2 + (h)) * HTB)
#define PG8_STAGE(bufoff, gbase, voff) do { _Pragma("unroll") for (int _i = 0; _i < 2; ++_i) \
        __builtin_amdgcn_global_load_lds((const unsigned*)((const char*)(gbase) + (voff)[_i]), (PG8_LAS unsigned*)(lds + (bufoff) + ldsw + _i * 8192), 16, 0, 0); } while (0)
#define PG8_LDA(dst, b, h) do { _Pragma("unroll") for (int m = 0; m < 4; ++m) _Pragma("unroll") for (int k = 0; k < 2; ++k) dst[m][k] = *(const PG8_LAS bf16x8*)(lds + PG8_SA(b, h) + aoff + m * 2048 + k * 1024); } while (0)
#define PG8_LDB(dst, b, h) do { _Pragma("unroll") for (int n = 0; n < 2; ++n) _Pragma("unroll") for (int k = 0; k < 2; ++k) dst[n][k] = *(const PG8_LAS bf16x8*)(lds + PG8_SB(b, h) + boff + n * 2048 + k * 1024); } while (0)
#define PG8_MMA(ai, bj, At, Bt) do { __builtin_amdgcn_s_setprio(1); _Pragma("unroll") for (int m = 0; m < 4; ++m) _Pragma("unroll") for (int n = 0; n < 2; ++n) _Pragma("unroll") for (int k = 0; k < 2; ++k) \
        acc[ai][bj][m][n] = __builtin_amdgcn_mfma_f32_16x16x32_bf16(Bt[n][k], At[m][k], acc[ai][bj][m][n], 0, 0, 0); __builtin_amdgcn_s_setprio(0); } while (0)
#define PG8_WAIT_V(n) asm volatile("s_waitcnt vmcnt(" #n ")" ::: "memory")
#define PG8_WAIT_L(n) asm volatile("s_waitcnt lgkmcnt(" #n ")" ::: "memory")
#define PG8_BAR __builtin_amdgcn_s_barrier()
#define PG8_SCHED __builtin_amdgcn_sched_barrier(0)
    Unit cur, nxt; int ui = 0;
    if (!S.next(0, cur)) return;
    f32x4 acc[2][2][4][2];
#pragma unroll
    for (int a = 0; a < 2; ++a)
#pragma unroll
        for (int b = 0; b < 2; ++b)
#pragma unroll
            for (int m = 0; m < 4; ++m)
#pragma unroll
                for (int n = 0; n < 2; ++n) acc[a][b][m][n] = (f32x4){0.f, 0.f, 0.f, 0.f};
    bf16x8 At[4][2], B0[2][2], B1[2][2];
    const char* cA = (const char*)g.A + (size_t)cur.pm * tstep; const char* cB = (const char*)g.Bt + (size_t)cur.pn * tstep;
    S.a_ready(cur);
    if constexpr (SP2) {
        PG8_STAGE(PG8_SB(0, 0), cB, voffB); PG8_STAGE(PG8_SB(0, 1), cB + hstep, voffB); PG8_STAGE(PG8_SA(0, 0), cA, voffA); PG8_STAGE(PG8_SA(0, 1), cA + hstep, voffA);
        if (wr == 1) PG8_BAR;
        PG8_WAIT_V(2); PG8_BAR;
        PG8_STAGE(PG8_SB(1, 0), cB + kstep, voffB); PG8_STAGE(PG8_SA(1, 0), cA + kstep, voffA); PG8_STAGE(PG8_SB(1, 1), cB + hstep + kstep, voffB);
        PG8_WAIT_V(6); PG8_BAR;
    } else {
        PG8_STAGE(PG8_SB(0, 0), cB, voffB); PG8_STAGE(PG8_SA(0, 0), cA, voffA); PG8_STAGE(PG8_SB(0, 1), cB + hstep, voffB); PG8_STAGE(PG8_SA(0, 1), cA + hstep, voffA);
        if (wr == 1) PG8_BAR;
        PG8_WAIT_V(4); PG8_BAR;
        PG8_STAGE(PG8_SB(1, 0), cB + kstep, voffB); PG8_STAGE(PG8_SA(1, 0), cA + kstep, voffA); PG8_STAGE(PG8_SB(1, 1), cB + hstep + kstep, voffB);
        PG8_WAIT_V(6); PG8_BAR;
    }
    for (;;) {
        const bool has_next = S.next(ui + 1, nxt);
        const char* nA = has_next ? (const char*)g.A + (size_t)nxt.pm * tstep : cA; const char* nB = has_next ? (const char*)g.Bt + (size_t)nxt.pn * tstep : cB;
        for (int t = 0; t < nt; t += 2) {
            const bool last = (t == nt - 2);
            const char* a1 = cA + (size_t)(t + 1) * kstep;
            const char* a2 = last ? nA : cA + (size_t)(t + 2) * kstep; const char* b2 = last ? nB : cB + (size_t)(t + 2) * kstep;
            const char* a3 = a2 + kstep; const char* b3 = b2 + kstep;
            if (last && has_next) S.a_ready(nxt);
            if constexpr (SP2) {
            PG8_LDB(B0, 0, 0); PG8_LDB(B1, 0, 1); PG8_SCHED; PG8_LDA(At, 0, 0); PG8_STAGE(PG8_SA(1, 1), a1 + hstep, voffA);
            PG8_WAIT_V(8); PG8_WAIT_L(0); PG8_BAR; PG8_MMA(0, 0, At, B0); PG8_MMA(0, 1, At, B1); PG8_BAR; PG8_SCHED;
            PG8_LDA(At, 0, 1); PG8_STAGE(PG8_SB(0, 0), b2, voffB); PG8_STAGE(PG8_SB(0, 1), b2 + hstep, voffB); PG8_STAGE(PG8_SA(0, 0), a2, voffA);
            PG8_WAIT_V(8); PG8_WAIT_L(0); PG8_BAR; PG8_MMA(1, 0, At, B0); PG8_MMA(1, 1, At, B1); PG8_BAR; PG8_SCHED;
            PG8_LDB(B0, 1, 0); PG8_LDB(B1, 1, 1); PG8_SCHED; PG8_LDA(At, 1, 0); PG8_STAGE(PG8_SA(0, 1), a2 + hstep, voffA);
            PG8_WAIT_V(8); PG8_WAIT_L(0); PG8_BAR; PG8_MMA(0, 0, At, B0); PG8_MMA(0, 1, At, B1); PG8_BAR; PG8_SCHED;
            PG8_LDA(At, 1, 1); PG8_STAGE(PG8_SB(1, 0), b3, voffB); PG8_STAGE(PG8_SB(1, 1), b3 + hstep, voffB); PG8_STAGE(PG8_SA(1, 0), a3, voffA);
            PG8_WAIT_V(8); PG8_WAIT_L(0); PG8_BAR; PG8_MMA(1, 0, At, B0); PG8_MMA(1, 1, At, B1); PG8_BAR; PG8_SCHED;
            } else {
            PG8_LDB(B0, 0, 0); PG8_SCHED; PG8_LDA(At, 0, 0); PG8_STAGE(PG8_SA(1, 1), a1 + hstep, voffA);
            PG8_WAIT_L(8); PG8_BAR; PG8_WAIT_L(0); PG8_MMA(0, 0, At, B0); PG8_BAR; PG8_SCHED;
            PG8_LDB(B1, 0, 1); PG8_STAGE(PG8_SB(0, 0), b2, voffB);
            PG8_BAR; PG8_WAIT_L(0); PG8_MMA(0, 1, At, B1); PG8_BAR;
            PG8_LDA(At, 0, 1); PG8_STAGE(PG8_SA(0, 0), a2, voffA);
            PG8_BAR; PG8_WAIT_L(0); PG8_MMA(1, 0, At, B0); PG8_BAR; PG8_SCHED;
            PG8_STAGE(PG8_SB(0, 1), b2 + hstep, voffB);
            PG8_WAIT_V(6); PG8_BAR; PG8_MMA(1, 1, At, B1); PG8_BAR;
            PG8_LDB(B0, 1, 0); PG8_SCHED; PG8_LDA(At, 1, 0); PG8_STAGE(PG8_SA(0, 1), a2 + hstep, voffA);
            PG8_WAIT_L(8); PG8_BAR; PG8_WAIT_L(0); PG8_MMA(0, 0, At, B0); PG8_BAR; PG8_SCHED;
            PG8_LDB(B1, 1, 1); PG8_STAGE(PG8_SB(1, 0), b3, voffB);
            PG8_BAR; PG8_WAIT_L(0); PG8_MMA(0, 1, At, B1); PG8_BAR;
            PG8_LDA(At, 1, 1); PG8_STAGE(PG8_SA(1, 0), a3, voffA);
            PG8_BAR; PG8_WAIT_L(0); PG8_MMA(1, 0, At, B0); PG8_BAR; PG8_SCHED;
            PG8_STAGE(PG8_SB(1, 1), b3 + hstep, voffB);
            PG8_WAIT_V(6); PG8_BAR; PG8_MMA(1, 1, At, B1); PG8_BAR;
            }
        }
        if constexpr (ALIGN_EPI) { if (wr == 0) PG8_BAR; }
        if constexpr (!Epi::AFTER_DRAIN) { E(acc, cur, wr, wc, fr, fq); S.done(cur); }
        if (!has_next) break;
#pragma unroll
        for (int a = 0; a < 2; ++a)
#pragma unroll
            for (int b = 0; b < 2; ++b)
#pragma unroll
                for (int m = 0; m < 4; ++m)
#pragma unroll
                    for (int n = 0; n < 2; ++n) acc[a][b][m][n] = (f32x4){0.f, 0.f, 0.f, 0.f};
        cur = nxt; cA = nA; cB = nB; ++ui;
        if constexpr (ALIGN_EPI) { if (wr == 1) PG8_BAR; }
    }
    PG8_WAIT_V(0);
    if constexpr (!ALIGN_EPI) { if (wr == 0) PG8_BAR; }
    PG8_BAR;
    if constexpr (Epi::AFTER_DRAIN) { E.fused(acc, cur, wr, wc, fr, fq, lds, wid, lane); S.done(cur); }
#undef PG8_SA
#undef PG8_SB
#undef PG8_STAGE
#undef PG8_LDA
#undef PG8_LDB
#undef PG8_MMA
#undef PG8_WAIT_V
#undef PG8_WAIT_L
#undef PG8_BAR
#undef PG8_SCHED
}
}
#include <hip/hip_bf16.h>
#include <cmath>
namespace attn_body {
using bf16=__hip_bfloat16;
using bf16x8=__attribute__((ext_vector_type(8)))short;
using s16x4=__attribute__((ext_vector_type(4)))short;
using f32x16=__attribute__((ext_vector_type(16)))float;
using u32x4=__attribute__((ext_vector_type(4)))unsigned;
using f32x4v=__attribute__((ext_vector_type(4)))float;
constexpr int BATCH=4,NHEAD=4,SEQ=8192,D=64,DM=2560,DMO=256;
constexpr int NW=8,QBLK=32,QB=QBLK*NW,KVBLK=64,NQB=SEQ/QB;
constexpr int ATTN_PITCH=DM, ATTN_UNIT_ROWS=QB;
__device__ __forceinline__ int crow(int r,int hi){return (r&3)+8*(r>>2)+4*hi;}
#define SBAR() __builtin_amdgcn_sched_barrier(0)
__device__ __forceinline__ void cmask(f32x16&p0,f32x16&p1,int jb,int qrel,int hi){
  const float NEG=-INFINITY; int kb=64*jb+4*hi;
  #pragma unroll
  for(int r=0;r<16;++r){int kv=kb+(r&3)+8*(r>>2); if(kv>qrel)p0[r]=NEG; if(kv+32>qrel)p1[r]=NEG;}
}

constexpr int NSLOT=3, SLOTB=8192;
constexpr int LDS_K=0, LDS_V=NSLOT*SLOTB, LDS_WS=2*NSLOT*SLOTB, LDS_OST=LDS_WS+NW*64*4, LDS_AUX=LDS_OST+NW*4096, LDS_BYTES=LDS_AUX+32768;
constexpr float C2=0.125f*1.4426950408889634f;
__device__ __forceinline__ void glds16(const void*gsrc,unsigned lds_dst){unsigned keep;
  asm volatile("s_mov_b32 %0, m0\n\ts_mov_b32 m0, %2\n\ts_nop 0\n\tglobal_load_lds_dwordx4 %1, off\n\ts_mov_b32 m0, %0":"=&s"(keep):"v"(gsrc),"s"(lds_dst):"memory");}
__device__ __forceinline__ float max3f(float a,float b,float c){float r;asm("v_max3_f32 %0, %1, %2, %3":"=v"(r):"v"(a),"v"(b),"v"(c));return r;}
__device__ __forceinline__ float max2f(float a,float b){float r;asm("v_max_f32_e32 %0, %1, %2":"=v"(r):"v"(a),"v"(b));return r;}
__device__ __forceinline__ float fadd_s(float a,float b){float r;asm("v_add_f32_e32 %0, %1, %2":"=v"(r):"v"(a),"v"(b));return r;}
__device__ __forceinline__ float fsub_s(float a,float b){float r;asm("v_sub_f32_e32 %0, %1, %2":"=v"(r):"v"(a),"v"(b));return r;}
typedef float f32x2_t __attribute__((ext_vector_type(2))); typedef __bf16 bf16x2_t __attribute__((ext_vector_type(2)));
__device__ __forceinline__ unsigned cvtpk_s(float lo,float hi){f32x2_t v={lo,hi};bf16x2_t b=__builtin_convertvector(v,bf16x2_t);return __builtin_bit_cast(unsigned,b);}
#define WAIT_BAR(N) asm volatile("s_waitcnt vmcnt(" #N ") lgkmcnt(0)\n\ts_barrier":::"memory")

__device__ __forceinline__ void qkt(f32x16&p0,f32x16&p1,const char*Kslot,const bf16x8*qr,int r32,int hi){
  const char*kb=Kslot+hi*1024+r32*16;
  #pragma unroll
  for(int d0=0;d0<4;++d0){
    const bf16x8 b0=*reinterpret_cast<const bf16x8*>(kb+d0*2048);
    const bf16x8 b1=*reinterpret_cast<const bf16x8*>(kb+d0*2048+512);
    {p0=__builtin_amdgcn_mfma_f32_32x32x16_bf16(b0,qr[d0],p0,0,0,0);p1=__builtin_amdgcn_mfma_f32_32x32x16_bf16(b1,qr[d0],p1,0,0,0);}}
}
typedef __attribute__((address_space(3))) const char* lds_cptr;
typedef short v4i16_t __attribute__((ext_vector_type(4)));
__device__ __forceinline__ void kload8(bf16x8*kf,lds_cptr kp){
  kf[0]=*(const __attribute__((address_space(3))) bf16x8*)(kp);      kf[1]=*(const __attribute__((address_space(3))) bf16x8*)(kp+512);
  kf[2]=*(const __attribute__((address_space(3))) bf16x8*)(kp+2048); kf[3]=*(const __attribute__((address_space(3))) bf16x8*)(kp+2560);
  kf[4]=*(const __attribute__((address_space(3))) bf16x8*)(kp+4096); kf[5]=*(const __attribute__((address_space(3))) bf16x8*)(kp+4608);
  kf[6]=*(const __attribute__((address_space(3))) bf16x8*)(kp+6144); kf[7]=*(const __attribute__((address_space(3))) bf16x8*)(kp+6656);
}
__device__ __forceinline__ void kload2(bf16x8*kf,lds_cptr kp,int j){ kf[2*j]=*(const __attribute__((address_space(3))) bf16x8*)(kp+j*2048); kf[2*j+1]=*(const __attribute__((address_space(3))) bf16x8*)(kp+j*2048+512); }
__device__ __forceinline__ s16x4 vtr(lds_cptr p){ return __builtin_bit_cast(s16x4,__builtin_amdgcn_ds_read_tr16_b64_v4i16((__attribute__((address_space(3))) v4i16_t*)p)); }
__device__ __forceinline__ float rowmax(const f32x16&p0,const f32x16&p1){
  float a=max3f(p0[0],p0[1],p1[0]),b=max3f(p0[2],p0[3],p1[1]);a=max3f(a,p1[2],p1[3]);
  #pragma unroll
  for(int r=4;r<16;r+=4){a=max3f(a,p0[r],p0[r+1]);b=max3f(b,p0[r+2],p0[r+3]);a=max3f(a,p1[r],p1[r+1]);b=max3f(b,p1[r+2],p1[r+3]);}
  const float m=max2f(a,b);
  auto rr=__builtin_amdgcn_permlane32_swap(__float_as_uint(m),__float_as_uint(m),false,false);
  return max2f(__uint_as_float(rr[0]),__uint_as_float(rr[1]));
}
__device__ __forceinline__ void pv(f32x16*o,int vb,bf16x8 pa0,bf16x8 pa1,bf16x8 pa2,bf16x8 pa3){
  #pragma unroll
  for(int d0=0;d0<2;++d0){s16x4 lo[4],hi[4];
    #pragma unroll
    for(int ks=0;ks<4;++ks){
      asm volatile("ds_read_b64_tr_b16 %0,%1 offset:%c2":"=&v"(lo[ks]):"v"(vb),"i"(d0*4096+ks*1024):"memory");
      asm volatile("ds_read_b64_tr_b16 %0,%1 offset:%c2":"=&v"(hi[ks]):"v"(vb),"i"(d0*4096+ks*1024+512):"memory");}
    asm volatile("s_waitcnt lgkmcnt(0)":::"memory");SBAR();
    #define PK(k) (bf16x8){lo[k][0],lo[k][1],lo[k][2],lo[k][3],hi[k][0],hi[k][1],hi[k][2],hi[k][3]}
    o[d0]=__builtin_amdgcn_mfma_f32_32x32x16_bf16(pa0,PK(0),o[d0],0,0,0);
    o[d0]=__builtin_amdgcn_mfma_f32_32x32x16_bf16(pa1,PK(1),o[d0],0,0,0);
    o[d0]=__builtin_amdgcn_mfma_f32_32x32x16_bf16(pa2,PK(2),o[d0],0,0,0);
    o[d0]=__builtin_amdgcn_mfma_f32_32x32x16_bf16(pa3,PK(3),o[d0],0,0,0);
    #undef PK
  }
}

#ifndef ATTN_STORE16
#define ATTN_STORE16(p,v) (*(u32x4*)(p)=(v))
#endif
template<int THRL,int MODE> __device__ __forceinline__ void attn_unit(int b,int h,int qb,const bf16*Q,const bf16*__restrict__ K,const bf16*__restrict__ V,bf16*O,const float*__restrict__ aux,int t0,char*shm){
  int tid_=threadIdx.x; asm volatile("":"+v"(tid_));
  const int tid=tid_,lane=tid&63,r32=lane&31,hi=lane>>5; const int wid=__builtin_amdgcn_readfirstlane(tid>>6);
  const long rowbase=(long)b*SEQ; const int q0=qb*QB; const lds_cptr shm3=(lds_cptr)shm;
  const bf16*Qw=Q+(rowbase+q0+wid*QBLK)*DM+h*D;
  const bf16*Kh=K+rowbase*DM+h*D,*Vh=V+rowbase*DM+h*D;
  const unsigned lds0=(unsigned)(uintptr_t)shm;
  float*wsf=(float*)(shm+LDS_WS)+wid*64;
  const bf16*ksrc=Kh+(long)lane*DM+wid*8;
  const bf16*vsrc=Vh+(long)(16*(wid&3)+(lane>>2))*DM+(wid>>2)*32+(lane&3)*8;
  const unsigned kdst=lds0+LDS_K+wid*1024, vdst=lds0+LDS_V+wid*1024;
  #define DMA_K(t,slot) glds16(ksrc+(long)(t)*KVBLK*DM,(unsigned)__builtin_amdgcn_readfirstlane(kdst+(slot)))
  #define DMA_V(t,slot) glds16(vsrc+(long)(t)*KVBLK*DM,(unsigned)__builtin_amdgcn_readfirstlane(vdst+(slot)))
  const int vb0=(int)(lds0+LDS_V)+((lane>>4)&1)*32+(lane&3)*8+(4*hi+((lane&15)>>2))*64;
  const char*Kbase=shm+LDS_K; bf16x8 kf[8];
  const lds_cptr kp0=shm3+LDS_K+hi*1024+r32*16; const lds_cptr vp0=shm3+LDS_V+((lane>>4)&1)*32+(lane&3)*8+(4*hi+((lane&15)>>2))*64;
  const int NT=(q0+QB)/KVBLK;
  typedef __attribute__((address_space(3))) float lds_f32; typedef __attribute__((address_space(3))) f32x4v lds_f32x4;
  lds_f32* const auxl=(lds_f32*)(shm3+LDS_AUX);
  unsigned mbits=0u;
  if(MODE==0){
    const float*src=aux+(long)(b*NHEAD+h)*SEQ;
    for(int i=t0*KVBLK+tid*4;i<q0+QB;i+=NW*64*4) *(lds_f32x4*)(auxl+i)=*(const f32x4v*)(src+i);
    asm volatile("s_waitcnt vmcnt(0) lgkmcnt(0)\n\ts_barrier":::"memory");
  } else {
    const float*src=aux+(long)(b*NHEAD+h)*(NQB*D);
    *(lds_f32x4*)(auxl+tid*4)=*(const f32x4v*)(src+tid*4);
    asm volatile("s_waitcnt vmcnt(0) lgkmcnt(0)\n\ts_barrier":::"memory");
    float qf[32];
    #pragma unroll
    for(int d0=0;d0<4;++d0){ const bf16x8 qv=*reinterpret_cast<const bf16x8*>(&Qw[(long)r32*DM+d0*16+hi*8]);
      #pragma unroll
      for(int j=0;j<8;++j) qf[d0*8+j]=__uint_as_float(((unsigned)(unsigned short)qv[j])<<16); }
    float b1=-INFINITY,b2=-INFINITY,b3=-INFINITY; int i1=-1,i2=-1,i3=-1;
    for(int n=0;n<qb;++n){ const lds_f32* kb=auxl+n*D+hi*8; float sa=0.f,sb=0.f;
      #pragma unroll
      for(int d0=0;d0<4;++d0){ const f32x4v ka=*(const lds_f32x4*)(kb+d0*16), kc=*(const lds_f32x4*)(kb+d0*16+4);
        sa+=qf[d0*8+0]*ka.x; sb+=qf[d0*8+1]*ka.y; sa+=qf[d0*8+2]*ka.z; sb+=qf[d0*8+3]*ka.w;
        sa+=qf[d0*8+4]*kc.x; sb+=qf[d0*8+5]*kc.y; sa+=qf[d0*8+6]*kc.z; sb+=qf[d0*8+7]*kc.w; }
      float s=sa+sb; s+=__shfl_xor(s,32);
      if(s>b1){b3=b2;i3=i2;b2=b1;i2=i1;b1=s;i1=n;} else if(s>b2){b3=b2;i3=i2;b2=s;i2=n;} else if(s>b3){b3=s;i3=n;} }
    mbits=(i1>=0?(1u<<i1):0u)|(i2>=0?(1u<<i2):0u)|(i3>=0?(1u<<i3):0u);
  }
  #define INITC(P0,P1,t) do{ if(MODE==0){ const lds_f32* bp_=auxl+(t)*KVBLK+4*hi; \
      _Pragma("unroll") for(int g_=0;g_<4;++g_){ const f32x4v a_=*(const lds_f32x4*)(bp_+8*g_), c_=*(const lds_f32x4*)(bp_+32+8*g_); \
        P0[4*g_]=a_.x-mhat;P0[4*g_+1]=a_.y-mhat;P0[4*g_+2]=a_.z-mhat;P0[4*g_+3]=a_.w-mhat; P1[4*g_]=c_.x-mhat;P1[4*g_+1]=c_.y-mhat;P1[4*g_+2]=c_.z-mhat;P1[4*g_+3]=c_.w-mhat; } } \
    else { const float nm_=((t)>=NT-4||((mbits>>((t)>>2))&1u))?-mhat:-INFINITY; \
      _Pragma("unroll") for(int r=0;r<16;++r){P0[r]=nm_;P1[r]=nm_;} asm volatile("":"+v"(P0),"+v"(P1)); } }while(0)
  DMA_K(t0,0);DMA_V(t0,0);DMA_K(t0+1,SLOTB);
  bf16x8 qr[4];
  #pragma unroll
  for(int d0=0;d0<4;++d0)qr[d0]=*reinterpret_cast<const bf16x8*>(&Qw[(long)r32*DM+d0*16+hi*8]);
  float mhat=0.f,l_reg=0.f;f32x16 o[2];o[0]=f32x16{};o[1]=f32x16{};
  const int qrel=wid*QBLK+r32;
  #define CMASK(P0,P1,t) do{int jb_=(t)-(NT-4); if(jb_>=0)cmask(P0,P1,jb_,qrel,hi);}while(0)
  bool resc=false;
  #define START(P0,P1) do{ const float rm=rowmax(P0,P1); resc=false; \
    { const float dl=(rm==-INFINITY)?0.f:rm; mhat=fadd_s(mhat,dl); \
      _Pragma("unroll") for(int r=0;r<16;++r){P0[r]=fsub_s(P0[r],dl);P1[r]=fsub_s(P1[r],dl);} \
      } \
    _Pragma("unroll") for(int r=0;r<16;++r)P0[r]=__builtin_amdgcn_exp2f(P0[r]); }while(0)
  #define RESC() do{ if(resc){ asm volatile("s_waitcnt lgkmcnt(0)":::"memory"); \
      _Pragma("unroll") for(int d_=0;d_<2;++d_) _Pragma("unroll") for(int r=0;r<16;++r)o[d_][r]*=wsf[crow(r,hi)]; } }while(0)
  f32x16 pA0,pA1,pB0,pB1;
  int sl_prev=0,sl_cur=0,sl_next=SLOTB;
  #define ROT() do{sl_prev=sl_cur;sl_cur=sl_next;sl_next=(sl_next==(NSLOT-1)*SLOTB)?0:sl_next+SLOTB;}while(0)
  DMA_K(t0+2,2*SLOTB);
  WAIT_BAR(3);
  INITC(pA0,pA1,t0);qkt(pA0,pA1,Kbase,qr,r32,hi);asm volatile("s_nop 15\n\ts_nop 7":"+v"(pA0),"+v"(pA1));CMASK(pA0,pA1,t0);
  START(pA0,pA1);
  _Pragma("unroll") for(int r=0;r<16;++r)pA1[r]=__builtin_amdgcn_exp2f(pA1[r]);
  WAIT_BAR(0);
  DMA_K(t0+3,0);DMA_V(t0+1,SLOTB);
  ROT();
  kload8(kf,kp0+sl_cur);
  WAIT_BAR(2);
  s16x4 vlo[8],vhi[8]; u32x4 pw0,pw1,pw2,pw3;
  #define PKW(P,B) cvtpk_s(P[B],P[B+1])
  #define PAF(k) __builtin_bit_cast(bf16x8,pw##k)
  #define VFR(i) (bf16x8){vlo[i][0],vlo[i][1],vlo[i][2],vlo[i][3],vhi[i][0],vhi[i][1],vhi[i][2],vhi[i][3]}
  #define PIN(x) asm volatile("":"+v"(x))
  #define MX3(a,b,c) __builtin_fmaxf(__builtin_fmaxf((a),(b)),(c))
  #define GAPA(MF,A0,A1,A2,A3,W0,W1,PW) do{ MF; sacc+=A0; sacc+=A1; sacc+=A2; sacc+=A3; PIN(sacc); W0; W1; PIN(PW); SBAR(); }while(0)
  #define EX(v) __builtin_amdgcn_exp2f(v)
  #define GAPB(MF,X,B) do{ MF; X[B]=EX(X[B]); X[B+1]=EX(X[B+1]); X[B+2]=EX(X[B+2]); X[B+3]=EX(X[B+3]); PIN(X); SBAR(); }while(0)
  #define VRD(i) do{ vlo[i]=vtr(vp_+(((i)>>2)*4096+((i)&3)*1024)); vhi[i]=vtr(vp_+(((i)>>2)*4096+((i)&3)*1024+512)); }while(0)
  #define KRD(G,j) do{ if(G){ kload2(kf,kp0+sl_next,j); SBAR(); } }while(0)
  #define STEP(C0,C1,P0,P1,t,GK,GV,GL) do{ SBAR(); INITC(C0,C1,t); SBAR(); \
    const lds_cptr vp_=vp0+sl_prev; \
    VRD(0); SBAR(); float sacc=(P0[0]+P0[1]); \
    GAPA(C0=__builtin_amdgcn_mfma_f32_32x32x16_bf16(kf[0],qr[0],C0,0,0,0), P0[2],P0[3],P0[4],P0[5],     pw0[0]=PKW(P0,0), pw0[1]=PKW(P0,2), pw0); \
    VRD(4); SBAR(); GAPA(C1=__builtin_amdgcn_mfma_f32_32x32x16_bf16(kf[1],qr[0],C1,0,0,0), P0[6],P0[7],P0[8],P0[9],     pw0[2]=PKW(P0,4), pw0[3]=PKW(P0,6), pw0); \
    VRD(1); SBAR(); GAPA(C0=__builtin_amdgcn_mfma_f32_32x32x16_bf16(kf[2],qr[1],C0,0,0,0),   P0[10],P0[11],P0[12],P0[13], pw1[0]=PKW(P0,8), pw1[1]=PKW(P0,10), pw1); \
    VRD(5); SBAR(); GAPA(C1=__builtin_amdgcn_mfma_f32_32x32x16_bf16(kf[3],qr[1],C1,0,0,0),   P0[14],P0[15],P1[0],P1[1],   pw1[2]=PKW(P0,12),pw1[3]=PKW(P0,14), pw1); \
    VRD(2); SBAR(); GAPA(C0=__builtin_amdgcn_mfma_f32_32x32x16_bf16(kf[4],qr[2],C0,0,0,0),   P1[2],P1[3],P1[4],P1[5],     pw2[0]=PKW(P1,0), pw2[1]=PKW(P1,2), pw2); \
    VRD(6); SBAR(); GAPA(C1=__builtin_amdgcn_mfma_f32_32x32x16_bf16(kf[5],qr[2],C1,0,0,0),   P1[6],P1[7],P1[8],P1[9],     pw2[2]=PKW(P1,4), pw2[3]=PKW(P1,6), pw2); \
    VRD(3); SBAR(); GAPA(C0=__builtin_amdgcn_mfma_f32_32x32x16_bf16(kf[6],qr[3],C0,0,0,0),   P1[10],P1[11],P1[12],P1[13], pw3[0]=PKW(P1,8), pw3[1]=PKW(P1,10), pw3); \
    VRD(7); SBAR(); GAPA(C1=__builtin_amdgcn_mfma_f32_32x32x16_bf16(kf[7],qr[3],C1,0,0,0),   P1[14],P1[15],0.f,0.f,       pw3[2]=PKW(P1,12),pw3[3]=PKW(P1,14), pw3); \
    l_reg+=sacc; \
    if(GK){DMA_K((t)+3,sl_cur);} if(GV){DMA_V((t)+1,sl_next);} \
    CMASK(C0,C1,t); \
    { float a=MX3(C0[0],C0[1],C1[0]),b=MX3(C0[2],C0[3],C1[1]); a=MX3(a,C1[2],C1[3]); \
      _Pragma("unroll") for(int r=4;r<16;r+=4){a=MX3(a,C0[r],C0[r+1]);b=MX3(b,C0[r+2],C0[r+3]);a=MX3(a,C1[r],C1[r+1]);b=MX3(b,C1[r+2],C1[r+3]);} \
      float rm=__builtin_fmaxf(a,b); { auto rr=__builtin_amdgcn_permlane32_swap(__float_as_uint(rm),__float_as_uint(rm),false,false); rm=__builtin_fmaxf(__uint_as_float(rr[0]),__uint_as_float(rr[1])); } \
      resc=false; \
      if(__builtin_expect(__any(rm>(float)THRL),0)){ const float dl=__builtin_fmaxf(rm,0.f); mhat+=dl; \
        _Pragma("unroll") for(int r=0;r<16;++r){C0[r]-=dl;C1[r]-=dl;} \
        const float f=__builtin_amdgcn_exp2f(-dl); l_reg*=f; if(hi==0)wsf[r32]=f; resc=true; } } \
    SBAR(); \
    GAPB(o[0]=__builtin_amdgcn_mfma_f32_32x32x16_bf16(PAF(0),VFR(0),o[0],0,0,0), C0,0); \
    GAPB(o[1]=__builtin_amdgcn_mfma_f32_32x32x16_bf16(PAF(0),VFR(4),o[1],0,0,0), C0,4); \
    KRD(GL,0); GAPB(o[0]=__builtin_amdgcn_mfma_f32_32x32x16_bf16(PAF(1),VFR(1),o[0],0,0,0), C0,8); \
    KRD(GL,1); GAPB(o[1]=__builtin_amdgcn_mfma_f32_32x32x16_bf16(PAF(1),VFR(5),o[1],0,0,0), C0,12); \
    KRD(GL,2); GAPB(o[0]=__builtin_amdgcn_mfma_f32_32x32x16_bf16(PAF(2),VFR(2),o[0],0,0,0), C1,0); \
    KRD(GL,3); GAPB(o[1]=__builtin_amdgcn_mfma_f32_32x32x16_bf16(PAF(2),VFR(6),o[1],0,0,0), C1,4); \
    GAPB(o[0]=__builtin_amdgcn_mfma_f32_32x32x16_bf16(PAF(3),VFR(3),o[0],0,0,0), C1,8); \
    GAPB(o[1]=__builtin_amdgcn_mfma_f32_32x32x16_bf16(PAF(3),VFR(7),o[1],0,0,0), C1,12); \
    }while(0)
  int t=t0+1;
  #undef CMASK
  #define CMASK(P0,P1,t) do{}while(0)
  for(;t+5<NT;t+=2){
    STEP(pB0,pB1,pA0,pA1,t,true,true,true);     WAIT_BAR(2); RESC(); ROT();
    STEP(pA0,pA1,pB0,pB1,t+1,true,true,true);   WAIT_BAR(2); RESC(); ROT();
  }
  #undef CMASK
  #define CMASK(P0,P1,t) do{int jb_=(t)-(NT-4); if(jb_>=0)cmask(P0,P1,jb_,qrel,hi);}while(0)
  #define ENDW(tt) do{ if((tt)+3<NT){WAIT_BAR(2);} else if((tt)+2<NT){WAIT_BAR(1);} else {WAIT_BAR(0);} }while(0)
  for(;t+1<NT;t+=2){
    STEP(pB0,pB1,pA0,pA1,t,(t+3<NT),(t+1<NT),(t+1<NT));       ENDW(t);   RESC(); ROT();
    STEP(pA0,pA1,pB0,pB1,t+1,(t+4<NT),(t+2<NT),(t+2<NT));     ENDW(t+1); RESC(); ROT();
  }
  STEP(pB0,pB1,pA0,pA1,NT-1,false,false,false); RESC();
  { float sacc=pB0[0]+pB0[1]; _Pragma("unroll") for(int r=2;r<16;++r)sacc+=pB0[r]; _Pragma("unroll") for(int r=0;r<16;++r)sacc+=pB1[r]; l_reg+=sacc;
    pw0=(u32x4){PKW(pB0,0),PKW(pB0,2),PKW(pB0,4),PKW(pB0,6)};pw1=(u32x4){PKW(pB0,8),PKW(pB0,10),PKW(pB0,12),PKW(pB0,14)};pw2=(u32x4){PKW(pB1,0),PKW(pB1,2),PKW(pB1,4),PKW(pB1,6)};pw3=(u32x4){PKW(pB1,8),PKW(pB1,10),PKW(pB1,12),PKW(pB1,14)};
    SBAR(); pv(o,vb0+sl_cur,PAF(0),PAF(1),PAF(2),PAF(3)); }
  #undef PKW
  #undef PAF
  #undef VFR
  #undef PIN
  #undef MX3
  #undef GAPA
  #undef GAPB
  #undef EX
  #undef VRD
  #undef KRD
  #undef STEP
  #undef ENDW
  {auto rr=__builtin_amdgcn_permlane32_swap(__float_as_uint(l_reg),__float_as_uint(l_reg),false,false);l_reg=__uint_as_float(rr[0])+__uint_as_float(rr[1]);}
  if(hi==0)wsf[32+r32]=l_reg;asm volatile("s_waitcnt lgkmcnt(0)":::"memory");
  float rli[16];
  #pragma unroll
  for(int r=0;r<16;++r)rli[r]=__builtin_amdgcn_rcpf(wsf[32+crow(r,hi)]);
  bf16*Ow=O+(rowbase+q0+wid*QBLK)*DMO+h*D;
  { bf16*stg=(bf16*)(shm+LDS_OST)+wid*2048;
    #pragma unroll
    for(int r=0;r<16;++r){const int orow=crow(r,hi);
      #pragma unroll
      for(int d0=0;d0<2;++d0)stg[orow*64+d0*32+r32]=__float2bfloat16(o[d0][r]*rli[r]);}
    asm volatile("s_waitcnt lgkmcnt(0)":::"memory");
    #pragma unroll
    for(int i=0;i<4;++i){const int row=i*8+(lane>>3),ch=lane&7; const u32x4 v=*(const u32x4*)(stg+row*64+ch*8); ATTN_STORE16(Ow+(long)row*DMO+ch*8,v);} }
  asm volatile("s_waitcnt lgkmcnt(0)\n\ts_barrier":::"memory");
  #undef INITC
  #undef DMA_K
  #undef DMA_V
  #undef CMASK
  #undef START
  #undef RESC
  #undef ROT
}
constexpr int ATTN_LDS_BYTES=LDS_BYTES;
struct AttnTensors { const bf16* P; bf16* Y; const float* kbias; const float* kbar; const float* nrm; };
__device__ __forceinline__ int fox_first_tile(const float* kbias_bh, const float* nrm_bh, int qb, int lane){
  const float qn=nrm_bh[2*qb]; float kn=0.f;
  for(int n=0;n<=qb;++n) kn=fmaxf(kn,nrm_bh[2*n+1]);
  const float thr=kbias_bh[qb*QB]-(2.0f*sqrtf(qn*kn)+160.0f);
  const int NT=(qb*QB+QB)/KVBLK; int first=NT;
  for(int base=0;base<NT;base+=64){ const int t=base+lane; const bool c=(t<NT)&&(kbias_bh[t*KVBLK+KVBLK-1]>thr);
    const unsigned long long m=__ballot(c); if(m){ first=base+__builtin_ctzll(m); break; } }
  first&=~1; if(first>NT-4)first=NT-4; return first;
}
template<int THRL=8> __device__ __forceinline__ void attn_phase(char*lds,const AttnTensors&T,int vcu,int G){
  for(int vc=vcu;vc<256;vc+=G){ const int s=vc&15, bh=vc>>4, b=bh>>2, h=bh&3;
    for(int i=0;i<4;++i){ const int qb=(i&1)?s:31-s;
#ifndef NO_MOBA
      if(i<2) attn_unit<THRL,1>(b,h,qb,T.P+1024,T.P+1280,T.P+1536,T.Y+(long)2*BATCH*SEQ*DMO,T.kbar,0,lds);
#endif
#ifndef NO_FOX
      if(i>=2){ int l_=threadIdx.x; asm volatile("":"+v"(l_)); const int t0=fox_first_tile(T.kbias+(long)bh*SEQ,T.nrm+(long)bh*NQB*2,qb,l_&63);
        attn_unit<THRL,0>(b,h,qb,T.P+1792,T.P+2048,T.P+2304,T.Y+(long)3*BATCH*SEQ*DMO,T.kbias,__builtin_amdgcn_readfirstlane(t0),lds); }
#endif
    } }
}
#undef SBAR
#undef WAIT_BAR
}
constexpr int NWAVES = 8;
constexpr int BATCH = 4, SEQ = 8192, T = BATCH * SEQ, D = 1024, FF = 4096, DEPTH = 4, INW = 6660, NA = 2560, NG = 4096, FCOL = 2560, GCOL = 2564;
constexpr float LN_EPS = 1e-5f, ALPHA = 1.681792830507429f;
constexpr size_t MiB = 1u << 20;
constexpr size_t WS_ADA = 0, WS_KBIAS = 512 * 1024, WS_LOGF = 1 * MiB, WS_KBAR = 1 * MiB + 512 * 1024, WS_ROPE = 2 * MiB;
constexpr size_t WS_WINA = 4 * MiB, WS_WG = 9 * MiB, WS_WB = 17 * MiB, WS_WO = 19 * MiB, WS_WUP = 21 * MiB, WS_WDN = 29 * MiB;
constexpr size_t WS_STATS = 38 * MiB;
constexpr size_t WS_Y = 40 * MiB;
constexpr size_t WS_U = 104 * MiB;
constexpr size_t WS_YB = 168 * MiB;
constexpr size_t WS_U8 = 456 * MiB;
constexpr size_t WS_R1 = 232 * MiB;
constexpr size_t WS_END = 488 * MiB;
constexpr size_t WS_NRM = 1 * MiB + 512 * 1024 + 192 * 1024;
constexpr size_t WS_BAR = 1 * MiB + 768 * 1024, BAR_ZERO_BYTES = 16384;
constexpr int RING_BYTES = 131072, LDS_BYTES = 147456;
typedef unsigned short bf16;
typedef float f32x4 __attribute__((ext_vector_type(4)));
typedef unsigned v4u __attribute__((ext_vector_type(4)));
typedef unsigned v2u __attribute__((ext_vector_type(2)));
__device__ __forceinline__ unsigned f2bf(float f) { unsigned u = __builtin_bit_cast(unsigned, f); return (u + 0x7fffu + ((u >> 16) & 1u)) >> 16; }
__device__ __forceinline__ unsigned pk2(float lo, float hi) { return pg8::cvt_pk_bf16(lo, hi); }
__device__ __forceinline__ float bflo(unsigned w) { return __uint_as_float(w << 16); }
__device__ __forceinline__ float bfhi(unsigned w) { return __uint_as_float(w & 0xffff0000u); }
__device__ __forceinline__ float wave_sum(float v) {
#pragma unroll
    for (int o = 1; o < 64; o <<= 1) v += __shfl_xor(v, o);
    return v;
}
struct Args {
    const float *x, *c; const int* pos; const float *w_ada, *b_ada, *w_in, *b_in, *w_pool, *pool_scale, *conv_w, *w_branch, *w_o, *ln1_g, *ln1_b, *w_up, *b_up, *w_down, *ln2_g, *ln2_b;
    float* out; unsigned char* ws;
};
struct Frame { unsigned char* lds; int tid, lane, wave, vcu, G; };

__device__ __forceinline__ void transpose_item(const float* W, int K, int N, int ldw, bf16* WT, float* scr, int item, int lane) {
    const int nblk = N / 32, kb = item / nblk, nb = item % nblk, k0 = 64 * kb, n0 = 32 * nb;
#pragma unroll 8
    for (int i = 0; i < 32; ++i) { const int kk = 2 * i + (lane >> 5); scr[kk * 33 + (lane & 31)] = W[(size_t)(k0 + kk) * ldw + n0 + (lane & 31)]; }
    asm volatile("s_waitcnt lgkmcnt(0)" ::: "memory");
    const int c = lane & 7;
#pragma unroll
    for (int j = 0; j < 4; ++j) { const int n = (lane >> 3) + 8 * j; const float* s = scr + (8 * c) * 33 + n;
        v4u o; o.x = pk2(s[0 * 33], s[1 * 33]); o.y = pk2(s[2 * 33], s[3 * 33]); o.z = pk2(s[4 * 33], s[5 * 33]); o.w = pk2(s[6 * 33], s[7 * 33]);
        *(v4u*)(WT + (size_t)(n0 + n) * K + k0 + 8 * c) = o; }
    asm volatile("s_waitcnt lgkmcnt(0)" ::: "memory");
}
__device__ __forceinline__ void transpose_item8(const float* W, int K, int N, int ldw, unsigned char* WT, float* scr, int item, int lane, float scale) {
    const int nblk = N / 32, kb = item / nblk, nb = item % nblk, k0 = 64 * kb, n0 = 32 * nb;
#pragma unroll 8
    for (int i = 0; i < 32; ++i) { const int kk = 2 * i + (lane >> 5); scr[kk * 33 + (lane & 31)] = W[(size_t)(k0 + kk) * ldw + n0 + (lane & 31)] * scale; }
    asm volatile("s_waitcnt lgkmcnt(0)" ::: "memory");
    const int c = lane & 7;
#pragma unroll
    for (int j = 0; j < 4; ++j) { const int n = (lane >> 3) + 8 * j; const float* s = scr + (8 * c) * 33 + n;
        int w0 = __builtin_amdgcn_cvt_pk_fp8_f32(s[0 * 33], s[1 * 33], 0, false); w0 = __builtin_amdgcn_cvt_pk_fp8_f32(s[2 * 33], s[3 * 33], w0, true);
        int w1 = __builtin_amdgcn_cvt_pk_fp8_f32(s[4 * 33], s[5 * 33], 0, false); w1 = __builtin_amdgcn_cvt_pk_fp8_f32(s[6 * 33], s[7 * 33], w1, true);
        v2u o; o.x = (unsigned)w0; o.y = (unsigned)w1;
        *(v2u*)(WT + (size_t)(n0 + n) * K + k0 + 8 * c) = o; }
    asm volatile("s_waitcnt lgkmcnt(0)" ::: "memory");
}
__device__ __forceinline__ void convert_weights(const Frame& F, const Args& a, int l) {
    float* scr = (float*)(F.lds + F.wave * 16384);
    const int gw = F.vcu * NWAVES + F.wave, NGW = F.G * NWAVES;
    constexpr int I_A = (D / 64) * (NA / 32), I_G = (D / 64) * (NG / 32), I_B = (256 / 64) * (D / 32), I_O = (D / 64) * (D / 32), I_U = (D / 64) * (FF / 32), I_D = (FF / 64) * (D / 32);
    constexpr int NITEMS = I_A + I_G + 4 * I_B + I_O + I_U + I_D;
    const float* win = a.w_in + (size_t)l * D * INW;
    for (int it = gw; it < NITEMS; it += NGW) {
        int r = it;
        if (r < I_A) { transpose_item(win, D, NA, INW, (bf16*)(a.ws + WS_WINA), scr, r, F.lane); continue; } r -= I_A;
        if (r < I_G) { transpose_item(win + GCOL, D, NG, INW, (bf16*)(a.ws + WS_WG), scr, r, F.lane); continue; } r -= I_G;
        if (r < 4 * I_B) { const int n = r / I_B; transpose_item(a.w_branch + ((size_t)l * 4 + n) * 256 * D, 256, D, D, (bf16*)(a.ws + WS_WB) + (size_t)n * D * 256, scr, r % I_B, F.lane); continue; } r -= 4 * I_B;
        if (r < I_O) { transpose_item(a.w_o + (size_t)l * D * D, D, D, D, (bf16*)(a.ws + WS_WO), scr, r, F.lane); continue; } r -= I_O;
        if (r < I_U) { transpose_item(a.w_up + (size_t)l * D * FF, D, FF, FF, (bf16*)(a.ws + WS_WUP), scr, r, F.lane); continue; } r -= I_U;
        transpose_item(a.w_down + (size_t)l * FF * D, FF, D, D, (bf16*)(a.ws + WS_WDN), scr, r, F.lane);
    }
}
__device__ __forceinline__ void sincos_f64(double x, float& sn, float& cs) {
    const double n = rint(x * 0.15915494309189535); double r = x - n * 6.283185307179586;
    const double k = rint(r * 0.6366197723675814); const double y = r - k * 1.5707963267948966;
    const double y2 = y * y;
    const double s = y * (1.0 + y2 * (-1.0 / 6 + y2 * (1.0 / 120 + y2 * (-1.0 / 5040 + y2 * (1.0 / 362880 + y2 * (-1.0 / 39916800 + y2 * (1.0 / 6227020800.0)))))));
    const double c = 1.0 + y2 * (-0.5 + y2 * (1.0 / 24 + y2 * (-1.0 / 720 + y2 * (1.0 / 40320 + y2 * (-1.0 / 3628800 + y2 * (1.0 / 479001600.0 + y2 * (-1.0 / 87178291200.0)))))));
    const int q = ((int)k) & 3;
    const double sr = (q == 0) ? s : (q == 1) ? c : (q == 2) ? -s : -c;
    const double cr = (q == 0) ? c : (q == 1) ? -s : (q == 2) ? -c : s;
    sn = (float)sr; cs = (float)cr;
}
__device__ __forceinline__ void phase_ada(const Frame& F, const Args& a) {
    float* sc = (float*)F.lds;
    if (blockIdx.x < 192) {
        for (int i = F.tid; i < BATCH * D; i += NWAVES * 64) { const float cv = a.c[i]; sc[i] = cv / (1.0f + __builtin_amdgcn_exp2f(-1.4426950408889634f * cv)); }
        __syncthreads();
        const int j = blockIdx.x, l = j / 48, colbase = (j % 48) * 128, cc = F.tid & 127, kq = F.tid >> 7;
        const float* w = a.w_ada + ((size_t)l * D + kq * 256) * (6 * D) + colbase + cc;
        const float* s0 = sc + kq * 256;
        float a0 = 0.f, a1 = 0.f, a2 = 0.f, a3 = 0.f;
#pragma unroll 32
        for (int k = 0; k < 256; ++k) { const float wv = w[(size_t)k * (6 * D)]; a0 += s0[k] * wv; a1 += s0[D + k] * wv; a2 += s0[2 * D + k] * wv; a3 += s0[3 * D + k] * wv; }
        float* red = sc + BATCH * D;
        red[(kq * 4 + 0) * 128 + cc] = a0; red[(kq * 4 + 1) * 128 + cc] = a1; red[(kq * 4 + 2) * 128 + cc] = a2; red[(kq * 4 + 3) * 128 + cc] = a3;
        __syncthreads();
        { const int b = F.tid >> 7; const float v = red[(0 * 4 + b) * 128 + cc] + red[(1 * 4 + b) * 128 + cc] + red[(2 * 4 + b) * 128 + cc] + red[(3 * 4 + b) * 128 + cc] + a.b_ada[l * 6 * D + colbase + cc];
          ((float*)(a.ws + WS_ADA))[(size_t)(l * BATCH + b) * 6 * D + colbase + cc] = v; }
        __syncthreads();
    }
    { const int gt = blockIdx.x * (NWAVES * 64) + F.tid, GT = F.G * NWAVES * 64; float* rope = (float*)(a.ws + WS_ROPE);
      for (int idx = gt; idx < T * 8; idx += GT) { const int t = idx >> 3, i = idx & 7;
          const float inv = (i == 0) ? 1.0f : (i == 1) ? 0.1939227432012558f : (i == 2) ? 0.03760603070259094f : (i == 3) ? 0.007292664609849453f : (i == 4) ? 0.0014142135623842478f : (i == 5) ? 0.00027424818836152554f : (i == 6) ? 5.318296098266728e-05f : 1.0313386155758053e-05f;
          const float ang = (float)a.pos[t] * inv; float sn, cs; sincos_f64((double)ang, sn, cs);
          rope[(size_t)t * 16 + i] = cs; rope[(size_t)t * 16 + 8 + i] = sn; } }
    convert_weights(F, a, 0);
}
__device__ __forceinline__ void phase_ln(const Frame& F, const Args& a, const float* in, float* xout, const float* lng, const float* lnb, const float* ada_sh, const float* ada_sc, bf16* U, int wf_l, float* stats_out = nullptr, const bf16* in16 = nullptr, unsigned char* U8 = nullptr) {
    float* wf = (float*)F.lds;
    if (wf_l >= 0) { const float* src = a.w_in + (size_t)wf_l * D * INW + FCOL;
        for (int i = F.tid; i < D; i += NWAVES * 64) *(f32x4*)(wf + 4 * i) = *(const f32x4*)(src + (size_t)i * INW);
        __syncthreads(); }
    const int gw = F.vcu * NWAVES + F.wave, NGW = F.G * NWAVES;
    if (stats_out && gw == 0) {
#pragma unroll
        for (int j = 0; j < 4; ++j) { *((f32x4*)(stats_out + 2 * T) + F.lane + 64 * j) = *((const f32x4*)lng + F.lane + 64 * j) * ALPHA; *((f32x4*)(stats_out + 2 * T + D) + F.lane + 64 * j) = *((const f32x4*)lnb + F.lane + 64 * j) * ALPHA; } }
    for (int m0 = gw; m0 < T; m0 += 2 * NGW) {
        f32x4 vv[2][4];
#pragma unroll
        for (int h = 0; h < 2; ++h) { const int m = m0 + h * NGW; if (m < T) {
            if (in16) { const v2u* xr = (const v2u*)(in16 + (size_t)m * D) + F.lane;
#pragma unroll
                for (int j = 0; j < 4; ++j) { const v2u q = xr[64 * j]; vv[h][j] = (f32x4){bflo(q.x), bfhi(q.x), bflo(q.y), bfhi(q.y)}; } }
            else { const f32x4* xr = (const f32x4*)(in + (size_t)m * D) + F.lane;
#pragma unroll
                for (int j = 0; j < 4; ++j) vv[h][j] = xr[64 * j]; } } }
#pragma unroll
        for (int h = 0; h < 2; ++h) { const int m = m0 + h * NGW; if (m >= T) break;
        f32x4 v[4];
#pragma unroll
        for (int j = 0; j < 4; ++j) v[j] = vv[h][j];
        if (lng) {
            float s = 0.f;
#pragma unroll
            for (int j = 0; j < 4; ++j) s += (v[j].x + v[j].y) + (v[j].z + v[j].w);
            const float mean = wave_sum(s) * (1.f / D); float s2 = 0.f;
#pragma unroll
            for (int j = 0; j < 4; ++j) { v[j] = v[j] - mean; s2 += (v[j].x * v[j].x + v[j].y * v[j].y) + (v[j].z * v[j].z + v[j].w * v[j].w); }
            const float rstd = __builtin_amdgcn_rsqf(wave_sum(s2) * (1.f / D) + LN_EPS);
            if (stats_out && F.lane == 0) { stats_out[2 * (size_t)m] = mean; stats_out[2 * (size_t)m + 1] = rstd; }
#pragma unroll
            for (int j = 0; j < 4; ++j) { const f32x4 g = *((const f32x4*)lng + F.lane + 64 * j), bb = *((const f32x4*)lnb + F.lane + 64 * j); v[j] = v[j] * rstd * g + bb; }
            if (xout) { f32x4* xo = (f32x4*)(xout + (size_t)m * D) + F.lane;
#pragma unroll
                for (int j = 0; j < 4; ++j) xo[64 * j] = v[j]; }
        }
        if (U) {
            const int b = m >> 13;
            float s = 0.f;
#pragma unroll
            for (int j = 0; j < 4; ++j) s += (v[j].x + v[j].y) + (v[j].z + v[j].w);
            const float mean = wave_sum(s) * (1.f / D); float s2 = 0.f;
#pragma unroll
            for (int j = 0; j < 4; ++j) { v[j] = v[j] - mean; s2 += (v[j].x * v[j].x + v[j].y * v[j].y) + (v[j].z * v[j].z + v[j].w * v[j].w); }
            const float rstd = __builtin_amdgcn_rsqf(wave_sum(s2) * (1.f / D) + LN_EPS);
            const f32x4* scp = (const f32x4*)(ada_sc + (size_t)b * 6 * D) + F.lane; const f32x4* shp = (const f32x4*)(ada_sh + (size_t)b * 6 * D) + F.lane;
            unsigned long long* o8 = (unsigned long long*)(U + (size_t)m * D) + F.lane;
            f32x4 fa = (f32x4){0.f, 0.f, 0.f, 0.f};
#pragma unroll
            for (int j = 0; j < 4; ++j) { const f32x4 scv = scp[64 * j], shv = shp[64 * j]; v[j] = v[j] * rstd * (scv + 1.0f) + shv;
                o8[64 * j] = (unsigned long long)pk2(v[j].x, v[j].y) | ((unsigned long long)pk2(v[j].z, v[j].w) << 32);
                if (U8) { int w8 = __builtin_amdgcn_cvt_pk_fp8_f32(v[j].x, v[j].y, 0, false); w8 = __builtin_amdgcn_cvt_pk_fp8_f32(v[j].z, v[j].w, w8, true); ((unsigned*)(U8 + (size_t)m * D))[F.lane + 64 * j] = (unsigned)w8; }
                if (wf_l >= 0) { const f32x4* wp = (const f32x4*)(wf + 4 * (4 * F.lane + 256 * j)); fa += wp[0] * v[j].x + wp[1] * v[j].y + wp[2] * v[j].z + wp[3] * v[j].w; } }
            if (wf_l >= 0) {
                fa.x = wave_sum(fa.x); fa.y = wave_sum(fa.y); fa.z = wave_sum(fa.z); fa.w = wave_sum(fa.w);
                if (F.lane < 4) { float z = (F.lane == 0) ? fa.x : (F.lane == 1) ? fa.y : (F.lane == 2) ? fa.z : fa.w; z += a.b_in[(size_t)wf_l * INW + FCOL + F.lane];
                    const float ls = fminf(z, 0.f) - 0.6931471805599453f * __builtin_amdgcn_logf(1.0f + __builtin_amdgcn_exp2f(-1.4426950408889634f * fabsf(z)));
                    ((float*)(a.ws + WS_LOGF))[(size_t)(b * 4 + F.lane) * SEQ + (m & (SEQ - 1))] = ls; }
            }
        }
            }
    }
    __syncthreads();
}
__device__ __forceinline__ void phase_prep(const Frame& F, const Args& a, int l) {
    bf16* P = (bf16*)(a.ws + WS_R1); bf16* Y = (bf16*)(a.ws + WS_Y); const float* rope = (const float*)(a.ws + WS_ROPE);
    const int tid = F.tid;
    { float* red = (float*)F.lds; float* red2 = red + 256 * 65;
      for (int item = blockIdx.x; item < 512; item += F.G) {
        const int tb = item >> 2, h = item & 3, i = tid & 255, which = tid >> 8; const size_t row = (size_t)tb * 256 + i;
        bf16* p = P + row * NA + 1024 + which * 256 + h * 64;
        const v4u c0 = *(const v4u*)p, c1 = *(const v4u*)(p + 8);
        float t1[8] = {bflo(c0.x), bfhi(c0.x), bflo(c0.y), bfhi(c0.y), bflo(c0.z), bfhi(c0.z), bflo(c0.w), bfhi(c0.w)};
        float t2[8] = {bflo(c1.x), bfhi(c1.x), bflo(c1.y), bfhi(c1.y), bflo(c1.z), bfhi(c1.z), bflo(c1.w), bfhi(c1.w)};
        const f32x4 cA = *(const f32x4*)(rope + row * 16), cB = *(const f32x4*)(rope + row * 16 + 4), sA = *(const f32x4*)(rope + row * 16 + 8), sB = *(const f32x4*)(rope + row * 16 + 12);
        const float cs[8] = {cA.x, cA.y, cA.z, cA.w, cB.x, cB.y, cB.z, cB.w}, sn[8] = {sA.x, sA.y, sA.z, sA.w, sB.x, sB.y, sB.z, sB.w};
        float r1[8], r2[8];
#pragma unroll
        for (int d = 0; d < 8; ++d) { r1[d] = t1[d] * cs[d] - t2[d] * sn[d]; r2[d] = t2[d] * cs[d] + t1[d] * sn[d]; }
        v4u o0, o1; o0.x = pk2(r1[0], r1[1]); o0.y = pk2(r1[2], r1[3]); o0.z = pk2(r1[4], r1[5]); o0.w = pk2(r1[6], r1[7]);
        o1.x = pk2(r2[0], r2[1]); o1.y = pk2(r2[2], r2[3]); o1.z = pk2(r2[4], r2[5]); o1.w = pk2(r2[6], r2[7]);
        *(v4u*)p = o0; *(v4u*)(p + 8) = o1;
        if (which == 1) {
            float* rr = red + i * 65;
#pragma unroll
            for (int d = 0; d < 8; ++d) { rr[d] = r1[d]; rr[8 + d] = r2[d]; }
#pragma unroll
            for (int ch = 2; ch < 8; ++ch) { const v4u cv = *(const v4u*)(p + 8 * ch);
                rr[8 * ch + 0] = bflo(cv.x); rr[8 * ch + 1] = bfhi(cv.x); rr[8 * ch + 2] = bflo(cv.y); rr[8 * ch + 3] = bfhi(cv.y);
                rr[8 * ch + 4] = bflo(cv.z); rr[8 * ch + 5] = bfhi(cv.z); rr[8 * ch + 6] = bflo(cv.w); rr[8 * ch + 7] = bfhi(cv.w); }
        }
        {
          const bf16* pf = P + row * NA + 1792 + which * 256 + h * 64; float ss = 0.f;
#pragma unroll
          for (int ch = 0; ch < 8; ++ch) { const v4u cv = *(const v4u*)(pf + 8 * ch);
              ss += bflo(cv.x) * bflo(cv.x) + bfhi(cv.x) * bfhi(cv.x) + bflo(cv.y) * bflo(cv.y) + bfhi(cv.y) * bfhi(cv.y) + bflo(cv.z) * bflo(cv.z) + bfhi(cv.z) * bfhi(cv.z) + bflo(cv.w) * bflo(cv.w) + bfhi(cv.w) * bfhi(cv.w); }
#pragma unroll
          for (int o = 1; o < 64; o <<= 1) ss = fmaxf(ss, __shfl_xor(ss, o));
          if (F.lane == 0) red2[512 + F.wave] = ss; }
        __syncthreads();
        { const int col = tid & 63, part = tid >> 6; float s = 0.f;
          for (int r = 0; r < 32; ++r) s += red[(part * 32 + r) * 65 + col];
          red2[part * 64 + col] = s; }
        __syncthreads();
        if (tid < 64) { float s = 0.f;
#pragma unroll
            for (int pp = 0; pp < 8; ++pp) s += red2[pp * 64 + tid];
            ((float*)(a.ws + WS_KBAR))[((size_t)((tb >> 5) * 4 + h) * 32 + (tb & 31)) * 64 + tid] = s * (1.0f / 256.0f);
            if (tid < 2) ((float*)(a.ws + WS_NRM))[((size_t)((tb >> 5) * 4 + h) * 32 + (tb & 31)) * 2 + tid] = fmaxf(fmaxf(red2[512 + 4 * tid], red2[512 + 4 * tid + 1]), fmaxf(red2[512 + 4 * tid + 2], red2[512 + 4 * tid + 3])) * 1.02f; }
        __syncthreads();
      } }
    { double* ds = (double*)F.lds;
      for (int seq = blockIdx.x; seq < 16; seq += F.G) {
        const float* lf = (const float*)(a.ws + WS_LOGF) + (size_t)seq * SEQ + 16 * tid; float* kb = (float*)(a.ws + WS_KBIAS) + (size_t)seq * SEQ + 16 * tid;
        f32x4 q[4];
#pragma unroll
        for (int j = 0; j < 4; ++j) q[j] = *(const f32x4*)(lf + 4 * j);
        double tot = 0.0;
#pragma unroll
        for (int j = 0; j < 4; ++j) tot += ((double)q[j].x + (double)q[j].y) + ((double)q[j].z + (double)q[j].w);
        double inc = tot;
#pragma unroll
        for (int o = 1; o < 64; o <<= 1) { const double up = __shfl_up(inc, o); if (F.lane >= o) inc += up; }
        if (F.lane == 63) ds[F.wave] = inc;
        __syncthreads();
        double run = inc - tot;
        for (int j = 0; j < F.wave; ++j) run += ds[j];
#pragma unroll
        for (int j = 0; j < 4; ++j) { f32x4 o; run += (double)q[j].x; o.x = (float)(run * -1.4426950408889634); run += (double)q[j].y; o.y = (float)(run * -1.4426950408889634);
            run += (double)q[j].z; o.z = (float)(run * -1.4426950408889634); run += (double)q[j].w; o.w = (float)(run * -1.4426950408889634); *(f32x4*)(kb + 4 * j) = o; }
        __syncthreads();
      } }
    { float* WP = (float*)F.lds; float* PL = WP + 4 * 64 * 64;
      const float* wpg = a.w_pool + (size_t)l * 4 * 64 * 64;
      for (int i = tid; i < 4 * 64 * 64 / 4; i += NWAVES * 64) *(f32x4*)(WP + 4 * i) = *(const f32x4*)(wpg + 4 * i);
      const int ch = tid & 255, half = tid >> 8, g = ch >> 6, w = 2 << g;
      const float pscale = a.pool_scale[l * 256 + ch];
#define POOL_LOAD(item_) do { const int row0_ = (item_) * 32 + half * 16, s0_ = row0_ & (SEQ - 1); \
          _Pragma("unroll") for (int j = 0; j < 31; ++j) { const int sj = s0_ - 15 + j; vals[j] = (sj >= 0 && j >= 16 - w) ? __uint_as_float(((unsigned)P[(size_t)(row0_ - 15 + j) * NA + ch]) << 16) : 0.f; } } while (0)
      float vals[31];
      if ((int)blockIdx.x < T / 32) POOL_LOAD((int)blockIdx.x);
      for (int item = blockIdx.x; item < T / 32; item += F.G) {
        const int row0 = item * 32 + half * 16, s0 = row0 & (SEQ - 1);
#define POOL_WIN(W_) do { _Pragma("unroll") for (int tt = 0; tt < 16; ++tt) { float sum = vals[15 + tt]; \
            _Pragma("unroll") for (int dd = 1; dd < (W_); ++dd) sum += vals[15 + tt - dd]; \
            const int cnt = min(s0 + tt + 1, (W_)); \
            PL[(half * 16 + tt) * 256 + ch] = sum * __builtin_amdgcn_rcpf((float)cnt) - vals[15 + tt]; } } while (0)
        if (g == 0) POOL_WIN(2); else if (g == 1) POOL_WIN(4); else if (g == 2) POOL_WIN(8); else POOL_WIN(16);
#undef POOL_WIN
        if (item + F.G < T / 32) POOL_LOAD(item + F.G);
        __syncthreads();
        { const int cq = tid & 63, tg = tid >> 6, g2 = cq >> 4, d0 = 4 * (cq & 15);
          f32x4 acc4[4];
#pragma unroll
          for (int t = 0; t < 4; ++t) acc4[t] = (f32x4){0.f, 0.f, 0.f, 0.f};
          const float* wb = WP + g2 * 4096 + d0; const float* pb = PL + (4 * tg) * 256 + g2 * 64;
          for (int c = 0; c < 64; c += 4) {
              const f32x4 w0 = *(const f32x4*)(wb + c * 64), w1 = *(const f32x4*)(wb + (c + 1) * 64), w2 = *(const f32x4*)(wb + (c + 2) * 64), w3 = *(const f32x4*)(wb + (c + 3) * 64);
#pragma unroll
              for (int t = 0; t < 4; ++t) { const f32x4 pv = *(const f32x4*)(pb + t * 256 + c); acc4[t] += w0 * pv.x + w1 * pv.y + w2 * pv.z + w3 * pv.w; } }
          const f32x4 ps = *(const f32x4*)(a.pool_scale + l * 256 + 4 * cq);
#pragma unroll
          for (int t = 0; t < 4; ++t) { const f32x4 o = acc4[t] * ps; v2u ov; ov.x = pk2(o.x, o.y); ov.y = pk2(o.z, o.w);
              *(v2u*)(Y + (size_t)(item * 32 + 4 * tg + t) * 256 + 4 * cq) = ov; } }
        __syncthreads();
      } }
    { bf16* Yc = Y + (size_t)T * 256; const float* cw = a.conv_w + (size_t)l * 3 * 256;
      const int gt = blockIdx.x * (NWAVES * 64) + tid, GT = F.G * NWAVES * 64; const int oc = (gt & 31) * 8;
      f32x4 cwv[3][2];
#pragma unroll
      for (int k = 0; k < 3; ++k) { cwv[k][0] = *(const f32x4*)(cw + k * 256 + oc); cwv[k][1] = *(const f32x4*)(cw + k * 256 + oc + 4); }
      for (int idx = gt; idx < (T / 4) * 32; idx += GT) { const int row0 = (idx >> 5) * 4, s0 = row0 & (SEQ - 1);
        const bf16* p = P + (size_t)row0 * NA + oc;
        v4u cc[6], hh[6], bb[4];
#pragma unroll
        for (int j = 0; j < 6; ++j) { if (s0 + j - 2 >= 0) { cc[j] = *(const v4u*)(p + (ptrdiff_t)(j - 2) * NA + 512); hh[j] = *(const v4u*)(p + (ptrdiff_t)(j - 2) * NA + 768); }
                                      else { cc[j] = (v4u){0u, 0u, 0u, 0u}; hh[j] = (v4u){0u, 0u, 0u, 0u}; } }
#pragma unroll
        for (int t = 0; t < 4; ++t) bb[t] = *(const v4u*)(p + (size_t)t * NA + 256);
        float v[6][8];
#pragma unroll
        for (int j = 0; j < 6; ++j) { v[j][0] = bflo(cc[j].x) * bflo(hh[j].x); v[j][1] = bfhi(cc[j].x) * bfhi(hh[j].x); v[j][2] = bflo(cc[j].y) * bflo(hh[j].y); v[j][3] = bfhi(cc[j].y) * bfhi(hh[j].y);
                                      v[j][4] = bflo(cc[j].z) * bflo(hh[j].z); v[j][5] = bfhi(cc[j].z) * bfhi(hh[j].z); v[j][6] = bflo(cc[j].w) * bflo(hh[j].w); v[j][7] = bfhi(cc[j].w) * bfhi(hh[j].w); }
#pragma unroll
        for (int t = 0; t < 4; ++t) { float z[8];
#pragma unroll
            for (int e = 0; e < 8; ++e) { const float w0 = e < 4 ? cwv[0][0][e] : cwv[0][1][e - 4], w1 = e < 4 ? cwv[1][0][e] : cwv[1][1][e - 4], w2 = e < 4 ? cwv[2][0][e] : cwv[2][1][e - 4];
                z[e] = w0 * v[t][e] + w1 * v[t + 1][e] + w2 * v[t + 2][e]; }
            const v4u b4 = bb[t];
            v4u o; o.x = pk2(z[0] * bflo(b4.x), z[1] * bfhi(b4.x)); o.y = pk2(z[2] * bflo(b4.y), z[3] * bfhi(b4.y)); o.z = pk2(z[4] * bflo(b4.z), z[5] * bfhi(b4.z)); o.w = pk2(z[6] * bflo(b4.w), z[7] * bfhi(b4.w));
            *(v4u*)(Yc + (size_t)(row0 + t) * 256 + oc) = o; } } }
    __syncthreads();
}
typedef short mbf16x8 __attribute__((ext_vector_type(8)));
typedef float mf32x16 __attribute__((ext_vector_type(16)));
__device__ __forceinline__ void phase_merge(const Frame& F, const bf16* Y, const bf16* WB, const unsigned char* G, bf16* Mout) {
    unsigned char* lb = F.lds;
    const int tid = F.tid, lane = F.lane, w = F.wave, i32 = lane & 31, hi = lane >> 5;
    for (int unit = F.vcu; unit < (T / 256) * (D / 128); unit += F.G) {
        const int pm = unit >> 3, pn = unit & 7, c0 = pn * 128; const size_t row = (size_t)pm * 256 + w * 32 + i32;
        mf32x16 sum[4];
#pragma unroll
        for (int cb = 0; cb < 4; ++cb)
#pragma unroll
            for (int r = 0; r < 16; ++r) sum[cb][r] = 0.f;
        for (int n = 0; n < 4; ++n) {
            const bf16* yp = Y + ((size_t)n * T + row) * 256 + 8 * hi;
            mbf16x8 yf[16];
#pragma unroll
            for (int ks = 0; ks < 16; ++ks) yf[ks] = *(const mbf16x8*)(yp + 16 * ks);
            __syncthreads();
            { const unsigned char* wp = (const unsigned char*)(WB + ((size_t)n * D + c0) * 256);
              v4u tmp[8];
#pragma unroll
              for (int i = 0; i < 8; ++i) tmp[i] = *(const v4u*)(wp + (size_t)(tid + 512 * i) * 16);
#pragma unroll
              for (int i = 0; i < 8; ++i) { const int q = tid + 512 * i; *(v4u*)(lb + (q >> 5) * 528 + (q & 31) * 16) = tmp[i]; } }
            __syncthreads();
            mf32x16 acc[4];
#pragma unroll
            for (int cb = 0; cb < 4; ++cb)
#pragma unroll
                for (int r = 0; r < 16; ++r) acc[cb][r] = 0.f;
            const unsigned char* lrow = lb + i32 * 528 + 16 * hi;
#pragma unroll
            for (int ks = 0; ks < 16; ++ks)
#pragma unroll
                for (int cb = 0; cb < 4; ++cb) { const mbf16x8 wf = *(const mbf16x8*)(lrow + cb * 32 * 528 + 32 * ks);
                    acc[cb] = __builtin_amdgcn_mfma_f32_32x32x16_bf16(wf, yf[ks], acc[cb], 0, 0, 0); }
            const unsigned char* gp = G + ((size_t)n * T + row) * D + c0 + 4 * hi;
#pragma unroll
            for (int cb = 0; cb < 4; ++cb)
#pragma unroll
                for (int g = 0; g < 4; ++g) { const unsigned gw = *(const unsigned*)(gp + 32 * cb + 8 * g);
                    sum[cb][4 * g + 0] += acc[cb][4 * g + 0] * (float)(gw & 255u); sum[cb][4 * g + 1] += acc[cb][4 * g + 1] * (float)((gw >> 8) & 255u);
                    sum[cb][4 * g + 2] += acc[cb][4 * g + 2] * (float)((gw >> 16) & 255u); sum[cb][4 * g + 3] += acc[cb][4 * g + 3] * (float)(gw >> 24); }
        }
        bf16* mp = Mout + row * D + c0 + 4 * hi;
#pragma unroll
        for (int cb = 0; cb < 4; ++cb)
#pragma unroll
            for (int g = 0; g < 4; ++g) { const float q = 1.0f / 255.0f; v2u o; o.x = pk2(sum[cb][4 * g + 0] * q, sum[cb][4 * g + 1] * q); o.y = pk2(sum[cb][4 * g + 2] * q, sum[cb][4 * g + 3] * q); *(v2u*)(mp + 32 * cb + 8 * g) = o; }
    }
    __syncthreads();
}
#ifdef PROBE
__device__ __forceinline__ void probe_dump(float* out, const bf16* src, int pitch, const float* small, int nsmall) {
    const size_t gt = (size_t)blockIdx.x * 512 + threadIdx.x, GT = (size_t)gridDim.x * 512;
    for (size_t i = gt; i < (size_t)T * D; i += GT) { const size_t row = i >> 10; const int c = (int)(i & 1023); float s = 0.f;
        for (int j = c; j < pitch; j += 1024) s += __uint_as_float(((unsigned)src[row * pitch + j]) << 16);
        if (small) s += small[i % nsmall];
        out[i] = s; }
}
#endif
#define LAS __attribute__((address_space(3)))
#define XB_TMO      128
#define XB_XCNT(j)  (256  + 64 * (j))
#define XB_XSUB(j)  (1280 + 64 * (j))
#define XB_XGEN(j)  (2304 + 64 * (j))
#define XB_TOP      3328
#define XB_TOPGEN   3392
#define XCD_BAR_WORDS 3456
#define XB_SPIN_CAP (1u << 18)

__device__ __forceinline__ unsigned xb_ld(unsigned* p)              { return __hip_atomic_load(p, __ATOMIC_RELAXED, __HIP_MEMORY_SCOPE_AGENT); }
__device__ __forceinline__ unsigned xb_add(unsigned* p, unsigned v) { return __hip_atomic_fetch_add(p, v, __ATOMIC_RELAXED, __HIP_MEMORY_SCOPE_AGENT); }
__device__ __forceinline__ unsigned xb_xcc_id() { return (unsigned)__builtin_amdgcn_s_getreg((3 << 11) | 20) & 0xFu; }
#define XB_SPIN(cond, bar) do { unsigned _sp = 0; while (cond) { __builtin_amdgcn_s_sleep(1); \
    if ((++_sp & 255u) == 0u) { if (xb_ld(&(bar)[XB_TMO])) break; if (_sp > XB_SPIN_CAP) { atomicAdd(&(bar)[XB_TMO], 1u); break; } } } } while (0)

struct XcdBarrier {
    unsigned* bar; unsigned x;
    volatile LAS unsigned* st;
};

__device__ __forceinline__ XcdBarrier xcd_barrier_post(unsigned* bar, volatile LAS unsigned* st) {
    XcdBarrier b; b.bar = bar; b.x = xb_xcc_id(); b.st = st;
    if (threadIdx.x == 0) (void)xb_add(&bar[XB_XCNT(b.x)], 1u);
    return b;
}
__device__ __forceinline__ void xcd_barrier_complete(unsigned* bar, unsigned x, unsigned& nloc, unsigned& nx) {
    const unsigned G = gridDim.x * gridDim.y * gridDim.z;
    unsigned sum, cnt, mine, sp = 0u;
    for (;;) {
        sum = 0u; cnt = 0u; mine = 0u;
#pragma unroll
        for (unsigned j = 0; j < 16; ++j) { const unsigned c = xb_ld(&bar[XB_XCNT(j)]); sum += c; cnt += (c > 0u) ? 1u : 0u; mine = (j == x) ? c : mine; }
        if (sum == G) break;
        __builtin_amdgcn_s_sleep(1);
        if ((++sp & 255u) == 0u) { if (xb_ld(&bar[XB_TMO])) break; if (sp > XB_SPIN_CAP) { atomicAdd(&bar[XB_TMO], 1u); break; } }
    }
    nloc = mine > 0u ? mine : 1u; nx = cnt > 0u ? cnt : 1u;
}

__device__ __forceinline__ void xcd_barrier(const XcdBarrier& b) {
    asm volatile("s_waitcnt vmcnt(0)" ::: "memory");
    __syncthreads();
    if (threadIdx.x == 0) {
        unsigned* bar = b.bar;
        __builtin_amdgcn_s_waitcnt(0);
        unsigned nloc = b.st[0], nx = b.st[1];
        if (nloc == 0u) { xcd_barrier_complete(bar, b.x, nloc, nx); b.st[0] = nloc; b.st[1] = nx; }
        const unsigned old = xb_add(&bar[XB_XSUB(b.x)], 1u);
        const unsigned gen = old / nloc;
        if (old + 1u == (gen + 1u) * nloc) {
            __builtin_amdgcn_fence(__ATOMIC_RELEASE, "agent");
            asm volatile("s_waitcnt vmcnt(0)" ::: "memory");
            const unsigned og = xb_add(&bar[XB_TOP], 1u);
            const unsigned tg = og / nx;
            if (og + 1u == (tg + 1u) * nx) xb_add(&bar[XB_TOPGEN], 1u);
            else XB_SPIN(xb_ld(&bar[XB_TOPGEN]) == tg, bar);
            __builtin_amdgcn_fence(__ATOMIC_ACQUIRE, "agent");
            xb_add(&bar[XB_XGEN(b.x)], 1u);
            asm volatile("s_waitcnt vmcnt(0)" ::: "memory");
        } else {
            XB_SPIN(xb_ld(&bar[XB_XGEN(b.x)]) == gen, bar);
            __builtin_amdgcn_fence(__ATOMIC_ACQUIRE, "agent");
            asm volatile("s_waitcnt vmcnt(0)" ::: "memory");
        }
    }
    __syncthreads();
}
constexpr int ARGV_OFF = RING_BYTES + 1024;
#define ARG_LIST(X) X(0, x) X(1, c) X(2, pos) X(3, w_ada) X(4, b_ada) X(5, w_in) X(6, b_in) X(7, w_pool) X(8, pool_scale) X(9, conv_w) X(10, w_branch) X(11, w_o) X(12, ln1_g) X(13, ln1_b) X(14, w_up) X(15, b_up) X(16, w_down) X(17, ln2_g) X(18, ln2_b) X(19, out) X(20, ws)
typedef __attribute__((address_space(3))) volatile unsigned lds_vu32;
template <class Tp> __device__ __forceinline__ Tp* ldarg(lds_vu32* argv, int i) {
    const unsigned lo = __builtin_amdgcn_readfirstlane(argv[2 * i]), hi = __builtin_amdgcn_readfirstlane(argv[2 * i + 1]);
    typedef __attribute__((address_space(1))) Tp* gptr_t;
    return (Tp*)(gptr_t)(((unsigned long long)hi << 32) | lo);
}
__device__ __forceinline__ Args load_args(lds_vu32* argv) {
    Args a;
#define X(i, name) a.name = ldarg<typename std::remove_pointer<decltype(a.name)>::type>(argv, i);
    ARG_LIST(X)
#undef X
    return a;
}
__global__ void __launch_bounds__(NWAVES * 64, 2) fwd_megakernel(Args a0) {
    extern __shared__ __attribute__((aligned(16))) unsigned char lds[];
    cg::grid_group grid = cg::this_grid();
    lds_vu32* argv = (lds_vu32*)(unsigned)ARGV_OFF;
    if (threadIdx.x == 0) {
#define X(i, name) { const unsigned long long v_ = (unsigned long long)a0.name; argv[2 * i] = (unsigned)v_; argv[2 * i + 1] = (unsigned)(v_ >> 32); }
        ARG_LIST(X)
#undef X
    }
    if (threadIdx.x == 0) { volatile LAS unsigned* st_ = (volatile LAS unsigned*)(unsigned)(ARGV_OFF + 512); st_[0] = 0u; st_[1] = 0u; }
    __syncthreads();
    (void)xcd_barrier_post((unsigned*)(a0.ws + WS_BAR), (volatile LAS unsigned*)(unsigned)(ARGV_OFF + 512));
    Frame F; F.lds = lds;
    PG8_LAS unsigned char* lds3 = (PG8_LAS unsigned char*)lds;
#define GSYNC_CG() do { asm volatile("s_waitcnt vmcnt(0) lgkmcnt(0)" ::: "memory"); __syncthreads(); if (threadIdx.x == 0) { asm volatile("buffer_wbl2 sc1\n\ts_waitcnt vmcnt(0)" ::: "memory"); } grid.sync(); asm volatile("buffer_inv sc1\n\ts_waitcnt vmcnt(0)" ::: "memory"); } while (0)
#define GSYNC() do { XcdBarrier b_; b_.bar = (unsigned*)(ldarg<unsigned char>(argv, 20) + WS_BAR); b_.x = xb_xcc_id(); b_.st = (volatile LAS unsigned*)(unsigned)(ARGV_OFF + 512); xcd_barrier(b_); } while (0)
#define PHASE_BEGIN() int t_ = threadIdx.x; asm volatile("" : "+v"(t_)); F.tid = t_; F.lane = t_ & 63; F.wave = __builtin_amdgcn_readfirstlane(t_ >> 6); \
    int G_ = gridDim.x, bx_ = blockIdx.x; asm volatile("" : "+s"(G_), "+s"(bx_)); F.G = G_; F.vcu = (G_ % 8 == 0) ? (bx_ % 8) * (G_ / 8) + bx_ / 8 : bx_; \
    unsigned ab_ = ARGV_OFF; asm volatile("" : "+v"(ab_)); const Args a = load_args((lds_vu32*)ab_); unsigned char* ws = a.ws; float* ADA = (float*)(ws + WS_ADA); bf16* U = (bf16*)(ws + WS_U); bf16* Y = (bf16*)(ws + WS_Y); bf16* R1 = (bf16*)(ws + WS_R1); \
    (void)ADA; (void)U; (void)Y; (void)R1
#ifndef ONLY
#define ON(k) 1
#else
#define ON(k) ((ONLY>>(k))&1)
#endif
    if (ON(0)) { PHASE_BEGIN(); phase_ada(F, a); }
    GSYNC_CG();
    if (ON(1)) { PHASE_BEGIN(); phase_ln(F, a, a.x, nullptr, nullptr, nullptr, ADA + 0 * D, ADA + 1 * D, U, 0); }
    GSYNC();
#if defined(PROBE) && PROBE == 12
    { PHASE_BEGIN(); const bf16* wsrc = (const bf16*)(ws + WS_WINA); const size_t gt = (size_t)blockIdx.x * 512 + threadIdx.x, GT = (size_t)gridDim.x * 512;
      for (size_t i = gt; i < (size_t)T * D; i += GT) a.out[i] = __uint_as_float(((unsigned)wsrc[i % (size_t)(33 * 512 * 1024)]) << 16); return; }
#endif
#if defined(PROBE) && PROBE == 1
    { PHASE_BEGIN(); probe_dump(a.out, U, 1024, (const float*)(ws + WS_ADA), 4 * 4 * 6144); return; }
#endif
    for (int l = 0; l < DEPTH; ++l) {
        if (ON(2)) { PHASE_BEGIN(); pg8::Gemm g{U, (bf16*)(ws + WS_WINA), T, NA, D}; pg8::StaticOrder S; S.init(T, NA, F.G, bx_);
          pg8::EpiAct<0> E{R1, NA, a.b_in + (size_t)l * INW, 0, 0, 4, 7, attn_body::C2};
          pg8::gemm_phase<pg8::EpiAct<0>, pg8::StaticOrder, true, true>(lds3, g, S, E); }
        GSYNC();
#if defined(PROBE) && PROBE == 2
        { PHASE_BEGIN(); probe_dump(a.out, R1, NA, (const float*)(ws + WS_LOGF), 16 * SEQ); return; }
#endif
        if (ON(3)) { PHASE_BEGIN(); phase_prep(F, a, l); }
        GSYNC();
#if defined(PROBE) && PROBE == 3
        { PHASE_BEGIN(); probe_dump(a.out, R1, NA, (const float*)(ws + WS_KBIAS), 16 * SEQ + 32768 * 0); return; }
#endif
#if defined(PROBE) && PROBE == 31
        { PHASE_BEGIN(); probe_dump(a.out, Y, 512, (const float*)(ws + WS_KBAR), 32768); return; }
#endif
        if (ON(4)) { PHASE_BEGIN(); const attn_body::AttnTensors AT{(const attn_body::bf16*)R1, (attn_body::bf16*)Y, (const float*)(ws + WS_KBIAS), (const float*)(ws + WS_KBAR), (const float*)(ws + WS_NRM)};
          attn_body::attn_phase<24>((char*)lds, AT, F.vcu, F.G); }
        GSYNC();
#if defined(PROBE) && PROBE == 4
        { PHASE_BEGIN(); probe_dump(a.out, Y + (size_t)2 * T * 256, 512, nullptr, 1); return; }
#endif
        if (ON(5)) { PHASE_BEGIN(); pg8::Gemm g{U, (bf16*)(ws + WS_WG), T, NG, D}; pg8::StaticOrder S; S.init(T, NG, F.G, bx_);
          pg8::EpiGate8 E{ws + WS_R1, a.b_in + (size_t)l * INW + GCOL, 1.0f};
          pg8::gemm_phase<pg8::EpiGate8, pg8::StaticOrder, true, true>(lds3, g, S, E); }
        GSYNC();
#if defined(PROBE) && PROBE == 5
        { PHASE_BEGIN(); probe_dump(a.out, R1, 4096, nullptr, 1); return; }
#endif
        if (ON(6)) { PHASE_BEGIN(); phase_merge(F, Y, (const bf16*)(ws + WS_WB), ws + WS_R1, U); }
        GSYNC();
#if defined(PROBE) && PROBE == 6
        { PHASE_BEGIN(); probe_dump(a.out, R1, 1024, nullptr, 1); return; }
#endif
        if (ON(7)) { PHASE_BEGIN(); pg8::Gemm g{U, (bf16*)(ws + WS_WO), T, D, D}; pg8::StaticOrder S; S.init(T, D, F.G, bx_);
          if (l == 0) { pg8::EpiRes<true> E{a.x, (bf16*)(ws + WS_YB), ADA + 2 * D, nullptr}; pg8::gemm_phase<pg8::EpiRes<true>, pg8::StaticOrder, true, true>(lds3, g, S, E); }
          else { pg8::EpiRes<false> E{ws + WS_YB, (bf16*)(ws + WS_YB), ADA + (size_t)l * BATCH * 6 * D + 2 * D, (const float*)(ws + WS_STATS)}; pg8::gemm_phase<pg8::EpiRes<false>, pg8::StaticOrder, true, true>(lds3, g, S, E); } }
        GSYNC();
#if defined(PROBE) && PROBE == 7
        return;
#endif
        if (ON(8)) { PHASE_BEGIN(); const float* ada_l = ADA + (size_t)l * BATCH * 6 * D; phase_ln(F, a, nullptr, nullptr, a.ln1_g + l * D, a.ln1_b + l * D, ada_l + 3 * D, ada_l + 4 * D, U, -1, (float*)(ws + WS_STATS), (const bf16*)(ws + WS_YB)); }
        GSYNC();
#if defined(PROBE) && PROBE == 8
        return;
#endif
        if (ON(9)) { PHASE_BEGIN(); pg8::Gemm g{U, (bf16*)(ws + WS_WUP), T, FF, D}; pg8::StaticOrder S; S.init(T, FF, F.G, bx_);
          pg8::EpiAct<2> E{R1, FF, a.b_up + (size_t)l * FF, 0, 0, -1, -1, 1.f};
          pg8::gemm_phase<pg8::EpiAct<2>, pg8::StaticOrder, true, true>(lds3, g, S, E); }
        GSYNC();
#if defined(PROBE) && PROBE == 9
        { PHASE_BEGIN(); probe_dump(a.out, R1, 4096, nullptr, 1); return; }
#endif
        if (ON(10)) { PHASE_BEGIN(); pg8::Gemm g{R1, (bf16*)(ws + WS_WDN), T, D, FF}; pg8::StaticOrder S; S.init(T, D, F.G, bx_);
          pg8::EpiRes<false> E{ws + WS_YB, (bf16*)(ws + WS_YB), ADA + (size_t)l * BATCH * 6 * D + 5 * D, (const float*)(ws + WS_STATS)};
          pg8::gemm_phase<pg8::EpiRes<false>, pg8::StaticOrder, true, true>(lds3, g, S, E); }
        GSYNC();
#if defined(PROBE) && PROBE == 10
        return;
#endif
        if (ON(11)) { PHASE_BEGIN();
            if (l + 1 < DEPTH) { const float* ada_n = ADA + (size_t)(l + 1) * BATCH * 6 * D;
                phase_ln(F, a, nullptr, nullptr, a.ln2_g + l * D, a.ln2_b + l * D, ada_n + 0 * D, ada_n + 1 * D, U, l + 1, (float*)(ws + WS_STATS), (const bf16*)(ws + WS_YB));
                convert_weights(F, a, l + 1); }
            else phase_ln(F, a, nullptr, a.out, a.ln2_g + l * D, a.ln2_b + l * D, nullptr, nullptr, nullptr, -1, nullptr, (const bf16*)(ws + WS_YB)); }
        if (l + 1 < DEPTH) GSYNC();
    }
}
extern "C" void kernel_launch(void* const* d_in, const int* in_sizes, int n_in, void* d_out, int out_size, void* d_ws, size_t ws_size, hipStream_t stream) {
    static int grid = 0;
    if (grid == 0) {
        if (n_in != 19 || out_size != T * D || ws_size < WS_END) { fprintf(stderr, "kernel_launch: unexpected shapes: n_in %d out %d ws %zu\n", n_in, out_size, ws_size); grid = -1; return; }
        int dev = 0, cus = 0, per_cu = 0;
        (void)hipGetDevice(&dev); (void)hipDeviceGetAttribute(&cus, hipDeviceAttributeMultiprocessorCount, dev);
        (void)hipFuncSetAttribute((const void*)fwd_megakernel, hipFuncAttributeMaxDynamicSharedMemorySize, LDS_BYTES);
        (void)hipOccupancyMaxActiveBlocksPerMultiprocessor(&per_cu, (const void*)fwd_megakernel, NWAVES * 64, LDS_BYTES);
        if (per_cu < 1) per_cu = 1;
        grid = cus * per_cu; if (grid > 256) grid = 256;
        fprintf(stderr, "kernel_launch: grid %d (cus %d, per_cu %d), ws %zu\n", grid, cus, per_cu, ws_size);
    }
    if (grid < 0) return;
    Args a{};
    a.x = (const float*)d_in[0]; a.c = (const float*)d_in[1]; a.pos = (const int*)d_in[2]; a.w_ada = (const float*)d_in[3]; a.b_ada = (const float*)d_in[4];
    a.w_in = (const float*)d_in[5]; a.b_in = (const float*)d_in[6]; a.w_pool = (const float*)d_in[7]; a.pool_scale = (const float*)d_in[8]; a.conv_w = (const float*)d_in[9];
    a.w_branch = (const float*)d_in[10]; a.w_o = (const float*)d_in[11]; a.ln1_g = (const float*)d_in[12]; a.ln1_b = (const float*)d_in[13]; a.w_up = (const float*)d_in[14];
    a.b_up = (const float*)d_in[15]; a.w_down = (const float*)d_in[16]; a.ln2_g = (const float*)d_in[17]; a.ln2_b = (const float*)d_in[18];
    a.out = (float*)d_out; a.ws = (unsigned char*)d_ws;
    (void)hipMemsetAsync((unsigned char*)d_ws + WS_BAR, 0, BAR_ZERO_BYTES, stream);
    void* args[] = {&a};
    const hipError_t e = hipLaunchCooperativeKernel((void*)fwd_megakernel, dim3(grid), dim3(NWAVES * 64), args, LDS_BYTES, stream);
    if (e != hipSuccess) fprintf(stderr, "kernel_launch: cooperative launch failed: %s (grid %d)\n", hipGetErrorString(e), grid);
}
```

```cpp
#include <hip/hip_runtime.h>
#include <hip/hip_cooperative_groups.h>
#include <hip/hip_bf16.h>
#include <cstdio>
#include <cstdint>
#include <cmath>
#include <type_traits>
namespace cg = cooperative_groups;
namespace pg8 {
#define PG8_LAS __attribute__((address_space(3)))
typedef unsigned short bf16_t;
typedef short bf16x8 __attribute__((ext_vector_type(8)));
typedef float f32x4 __attribute__((ext_vector_type(4)));
typedef unsigned u32x4 __attribute__((ext_vector_type(4)));
constexpr int BM = 256, BK = 64, HALF = 128, HTB = HALF * BK * 2  , STAGE_BYTES = 8 * HTB, NXCD = 8, WGM = 8;

__host__ __device__ __forceinline__ int lds_byte(int r, int c) { const int st = (r >> 4) * 2 + (c >> 5), rr = r & 15, cc = c & 31, ob = rr * 64 + cc * 2; return st * 1024 + (ob ^ (((ob >> 9) & 1) << 5)); }
__host__ __device__ __forceinline__ void stage_rc(int b, int& R, int& C) { const int st = b / 1024, sb = b % 1024, swz = sb ^ (((sb >> 9) & 1) << 5); R = (st >> 1) * 16 + swz / 64; C = (st & 1) * 32 + (swz % 64) / 2; }
__host__ __device__ __forceinline__ int perm32(int rho) { const int n = rho >> 4, i = rho & 15; return 8 * (i >> 2) + 4 * n + (i & 3); }

struct Unit { int pm, pn; };
struct Gemm { const bf16_t* A; const bf16_t* Bt; int M, N, K; };

struct StaticOrder {
    int nM, nN, nwg, G, c;
    __host__ __device__ void init(int M, int N, int G_, int c_) { nM = M / BM; nN = N / BM; nwg = nM * nN; G = G_; c = c_; }
    __host__ __device__ bool next(int i, Unit& u) const {
        const long L = (long)i * G + c; if (L >= nwg) return false;
        int wgid = (int)L; { const int q = nwg / NXCD, r = nwg % NXCD, xcd = wgid % NXCD, off = wgid / NXCD; wgid = (xcd < r ? xcd * (q + 1) : r * (q + 1) + (xcd - r) * q) + off; }
        const int nig = WGM * nN, gid = wgid / nig, fm = gid * WGM, gsz = (nM - fm) < WGM ? (nM - fm) : WGM;
        u.pm = fm + ((wgid % nig) % gsz); u.pn = (wgid % nig) / gsz; return true;
    }
    __device__ __forceinline__ void a_ready(const Unit&) const {}
    __device__ __forceinline__ void done(const Unit&) const {}
};

typedef float f32x2c_t __attribute__((ext_vector_type(2))); typedef __bf16 bf16x2c_t __attribute__((ext_vector_type(2)));
__device__ __forceinline__ unsigned cvt_pk_bf16(float lo, float hi) { f32x2c_t v = {lo, hi}; bf16x2c_t b = __builtin_convertvector(v, bf16x2c_t); return __builtin_bit_cast(unsigned, b); }
typedef float f32x2 __attribute__((ext_vector_type(2)));
__device__ __forceinline__ float bf_lo(unsigned w) { return __uint_as_float(w << 16); }
__device__ __forceinline__ float bf_hi(unsigned w) { return __uint_as_float(w & 0xffff0000u); }
template <int ACT> struct EpiAct {
    static constexpr bool PERM = true, AFTER_DRAIN = false;
    bf16_t* O; int ldc; const float* bias; int split_cols; size_t split_stride; int qs0, qs1; float qscale;
    __device__ __forceinline__ float act(float v) const {
        if (ACT == 1) return __builtin_amdgcn_rcpf(1.0f + __builtin_amdgcn_exp2f(-1.4426950408889634f * v));
        if (ACT == 2) { const float r = v > 0.f ? v : 0.f; return r * r; }
        return v;
    }
    __device__ __forceinline__ void operator()(const f32x4 (&acc)[2][2][4][2], const Unit& u, int wr, int wc, int fr, int fq) const {
        const int row0 = u.pm * BM + wr * 64 + fr; int colt = u.pn * BM; bf16_t* base = O;
        if (split_cols) { const int t = colt / split_cols; base += (size_t)t * split_stride; colt -= t * split_cols; }
        const float sc = (u.pn == qs0 || u.pn == qs1) ? qscale : 1.f;
        const int col0 = colt + wc * 32 + 8 * fq, bcol0 = u.pn * BM + wc * 32 + 8 * fq;
        f32x4 bv[2][2];
#pragma unroll
        for (int bj = 0; bj < 2; ++bj)
#pragma unroll
            for (int n = 0; n < 2; ++n) bv[bj][n] = bias ? *(const f32x4*)(bias + bcol0 + bj * HALF + 4 * n) : (f32x4){0.f, 0.f, 0.f, 0.f};
#pragma unroll
        for (int ai = 0; ai < 2; ++ai)
#pragma unroll
            for (int m = 0; m < 4; ++m) { bf16_t* rowp = base + (size_t)(row0 + ai * HALF + m * 16) * ldc + col0;
#pragma unroll
                for (int bj = 0; bj < 2; ++bj) { f32x4 v0 = acc[ai][bj][m][0] + bv[bj][0], v1 = acc[ai][bj][m][1] + bv[bj][1];
                    if (ACT != 0) { v0 = (f32x4){act(v0[0]), act(v0[1]), act(v0[2]), act(v0[3])}; v1 = (f32x4){act(v1[0]), act(v1[1]), act(v1[2]), act(v1[3])}; }
                    v0 = v0 * sc; v1 = v1 * sc; u32x4 w; w.x = cvt_pk_bf16(v0[0], v0[1]); w.y = cvt_pk_bf16(v0[2], v0[3]); w.z = cvt_pk_bf16(v1[0], v1[1]); w.w = cvt_pk_bf16(v1[2], v1[3]);
                    *(u32x4*)(rowp + bj * HALF) = w; } }
    }
};
struct EpiGate8 {
    static constexpr bool PERM = true, AFTER_DRAIN = false;
    unsigned char* O; const float* bias; float pre;
    __device__ __forceinline__ unsigned q8(float v) const { const float s = __builtin_amdgcn_rcpf(1.0f + __builtin_amdgcn_exp2f(-1.4426950408889634f * v)); return (unsigned)(s * 255.0f + 0.5f); }
    __device__ __forceinline__ void operator()(const f32x4 (&acc)[2][2][4][2], const Unit& u, int wr, int wc, int fr, int fq) const {
        const int row0 = u.pm * BM + wr * 64 + fr; const int colt = u.pn * BM; const int t = colt >> 10;
        unsigned char* base = O + (size_t)t * ((size_t)32768 * 1024);
        const int col0 = (colt & 1023) + wc * 32 + 8 * fq, bcol0 = colt + wc * 32 + 8 * fq;
        f32x4 bv[2][2];
#pragma unroll
        for (int bj = 0; bj < 2; ++bj)
#pragma unroll
            for (int n = 0; n < 2; ++n) bv[bj][n] = *(const f32x4*)(bias + bcol0 + bj * HALF + 4 * n);
#pragma unroll
        for (int ai = 0; ai < 2; ++ai)
#pragma unroll
            for (int m = 0; m < 4; ++m) { unsigned char* rowp = base + (size_t)(row0 + ai * HALF + m * 16) * 1024 + col0;
#pragma unroll
                for (int bj = 0; bj < 2; ++bj) { const f32x4 v0 = acc[ai][bj][m][0] * pre + bv[bj][0], v1 = acc[ai][bj][m][1] * pre + bv[bj][1];
                    typedef unsigned u32x2 __attribute__((ext_vector_type(2))); u32x2 w;
                    w.x = q8(v0[0]) | (q8(v0[1]) << 8) | (q8(v0[2]) << 16) | (q8(v0[3]) << 24); w.y = q8(v1[0]) | (q8(v1[1]) << 8) | (q8(v1[2]) << 16) | (q8(v1[3]) << 24);
                    *(u32x2*)(rowp + bj * HALF) = w; }
                asm volatile("" ::: "memory"); }
    }
};
template <bool XF32> struct EpiRes {
    static constexpr bool PERM = true, AFTER_DRAIN = false;
    static constexpr int gate_bstride = 6 * 1024, NROWS = 32768; static constexpr float alpha = 1.681792830507429f;
    const void* xin; bf16_t* yout; const float* gate; const float* stats;
    __device__ __forceinline__ void operator()(const f32x4 (&acc)[2][2][4][2], const Unit& u, int wr, int wc, int fr, int fq) const {
        const int row0 = u.pm * BM + wr * 64 + fr, col0 = u.pn * BM + wc * 32 + 8 * fq; const int b = (u.pm * BM) >> 13;
        const float* gp = gate + (size_t)b * gate_bstride + col0;
        f32x4 gv[2][2], lg[2][2], lb[2][2];
#pragma unroll
        for (int bj = 0; bj < 2; ++bj)
#pragma unroll
            for (int n = 0; n < 2; ++n) { gv[bj][n] = *(const f32x4*)(gp + bj * HALF + 4 * n);
                if (!XF32) { lg[bj][n] = *(const f32x4*)(stats + 2 * NROWS + col0 + bj * HALF + 4 * n); lb[bj][n] = *(const f32x4*)(stats + 2 * NROWS + 1024 + col0 + bj * HALF + 4 * n); } }
#pragma unroll
        for (int ai = 0; ai < 2; ++ai)
#pragma unroll
            for (int mh = 0; mh < 2; ++mh) {
                f32x4 xv[2][2][2]; f32x2 st[2];
#pragma unroll
                for (int mm = 0; mm < 2; ++mm) { const int r = row0 + ai * HALF + (2 * mh + mm) * 16; const size_t off = (size_t)r * 1024 + col0;
                    if (XF32) { st[mm] = (f32x2){0.f, 0.f};
#pragma unroll
                        for (int bj = 0; bj < 2; ++bj)
#pragma unroll
                            for (int n = 0; n < 2; ++n) xv[mm][bj][n] = *(const f32x4*)((const float*)xin + off + bj * HALF + 4 * n);
                    } else { st[mm] = *(const f32x2*)(stats + 2 * (size_t)r);
#pragma unroll
                        for (int bj = 0; bj < 2; ++bj) { const u32x4 yw = *(const u32x4*)((const bf16_t*)xin + off + bj * HALF);
                            xv[mm][bj][0] = (f32x4){bf_lo(yw.x), bf_hi(yw.x), bf_lo(yw.y), bf_hi(yw.y)}; xv[mm][bj][1] = (f32x4){bf_lo(yw.z), bf_hi(yw.z), bf_lo(yw.w), bf_hi(yw.w)}; } } }
                asm volatile("" ::: "memory");
#pragma unroll
                for (int mm = 0; mm < 2; ++mm) { const int m = 2 * mh + mm; const size_t off = (size_t)(row0 + ai * HALF + m * 16) * 1024 + col0;
#pragma unroll
                    for (int bj = 0; bj < 2; ++bj) { f32x4 o[2];
#pragma unroll
                        for (int n = 0; n < 2; ++n) { f32x4 xa;
                            if (!XF32) xa = (xv[mm][bj][n] - st[mm].x) * st[mm].y * lg[bj][n] + lb[bj][n];
                            else xa = xv[mm][bj][n] * alpha;
                            o[n] = xa + gv[bj][n] * acc[ai][bj][m][n]; }
                        u32x4 w; w.x = cvt_pk_bf16(o[0][0], o[0][1]); w.y = cvt_pk_bf16(o[0][2], o[0][3]); w.z = cvt_pk_bf16(o[1][0], o[1][1]); w.w = cvt_pk_bf16(o[1][2], o[1][3]);
                        *(u32x4*)(yout + off + bj * HALF) = w; } }
                asm volatile("" ::: "memory"); }
    }
};
struct EpiMerge {
    static constexpr bool PERM = true, AFTER_DRAIN = false;
    const bf16_t* G; float* macc; bf16_t* Mout; int mode;
    __device__ __forceinline__ void operator()(const f32x4 (&acc)[2][2][4][2], const Unit& u, int wr, int wc, int fr, int fq) const {
        const int row0 = u.pm * BM + wr * 64 + fr, col0 = u.pn * BM + wc * 32 + 8 * fq;
#pragma unroll
        for (int ai = 0; ai < 2; ++ai)
#pragma unroll
            for (int m = 0; m < 4; ++m) { const size_t off = (size_t)(row0 + ai * HALF + m * 16) * 1024 + col0;
#pragma unroll
                for (int bj = 0; bj < 2; ++bj) { const u32x4 gw = *(const u32x4*)(G + off + bj * HALF);
                    f32x4 v0 = acc[ai][bj][m][0] * (f32x4){bf_lo(gw.x), bf_hi(gw.x), bf_lo(gw.y), bf_hi(gw.y)};
                    f32x4 v1 = acc[ai][bj][m][1] * (f32x4){bf_lo(gw.z), bf_hi(gw.z), bf_lo(gw.w), bf_hi(gw.w)};
                    if (mode != 0) { v0 += *(const f32x4*)(macc + off + bj * HALF); v1 += *(const f32x4*)(macc + off + bj * HALF + 4); }
                    if (mode != 2) { *(f32x4*)(macc + off + bj * HALF) = v0; *(f32x4*)(macc + off + bj * HALF + 4) = v1; }
                    else { u32x4 w; w.x = cvt_pk_bf16(v0[0], v0[1]); w.y = cvt_pk_bf16(v0[2], v0[3]); w.z = cvt_pk_bf16(v1[0], v1[1]); w.w = cvt_pk_bf16(v1[2], v1[3]); *(u32x4*)(Mout + off + bj * HALF) = w; } }
                asm volatile("" ::: "memory"); }
    }
};

template <class Epi, class Sched, bool ALIGN_EPI = false, bool SP2 = false>
__device__ __forceinline__ void gemm_phase(PG8_LAS unsigned char* lds, const Gemm g, const Sched& S, const Epi& E) {
    int tid_ = threadIdx.x; asm volatile("" : "+v"(tid_)); tid_ &= 511;
    const int tid = tid_, wid = __builtin_amdgcn_readfirstlane(tid >> 6), lane = tid & 63, wr = wid >> 2, wc = wid & 3, fr = lane & 15, fq = lane >> 4;
    const int K = g.K, nt = K / BK;
    unsigned voffA[2], voffB[2];
#pragma unroll
    for (int i = 0; i < 2; ++i) { int R, C; stage_rc(tid * 16 + i * 8192, R, C); const int Rb = Epi::PERM ? ((R & ~31) + perm32(R & 31)) : R;
        voffA[i] = (unsigned)(R * K + C) * 2u; voffB[i] = (unsigned)(Rb * K + C) * 2u; }
    const size_t kstep = (size_t)(BK * 2);
    const size_t hstep = (size_t)HALF * K * 2;
    const size_t tstep = 2 * hstep;
    const unsigned ldsw = (unsigned)wid * 1024u;
    const int aoff = lds_byte(wr * 64 + fr, fq * 8), boff = lds_byte(wc * 32 + fr, fq * 8);
#define PG8_SA(b, h) (((b) * 2 + (h)) * HTB)
#define PG8_SB(b, h) ((4 + (b) * 2 + (h)) * HTB)
#define PG8_STAGE(bufoff, gbase, voff) do { _Pragma("unroll") for (int _i = 0; _i < 2; ++_i) \
        __builtin_amdgcn_global_load_lds((const unsigned*)((const char*)(gbase) + (voff)[_i]), (PG8_LAS unsigned*)(lds + (bufoff) + ldsw + _i * 8192), 16, 0, 0); } while (0)
#define PG8_LDA(dst, b, h) do { _Pragma("unroll") for (int m = 0; m < 4; ++m) _Pragma("unroll") for (int k = 0; k < 2; ++k) dst[m][k] = *(const PG8_LAS bf16x8*)(lds + PG8_SA(b, h) + aoff + m * 2048 + k * 1024); } while (0)
#define PG8_LDB(dst, b, h) do { _Pragma("unroll") for (int n = 0; n < 2; ++n) _Pragma("unroll") for (int k = 0; k < 2; ++k) dst[n][k] = *(const PG8_LAS bf16x8*)(lds + PG8_SB(b, h) + boff + n * 2048 + k * 1024); } while (0)
#define PG8_MMA(ai, bj, At, Bt) do { __builtin_amdgcn_s_setprio(1); _Pragma("unroll") for (int m = 0; m < 4; ++m) _Pragma("unroll") for (int n = 0; n < 2; ++n) _Pragma("unroll") for (int k = 0; k < 2; ++k) \
        acc[ai][bj][m][n] = __builtin_amdgcn_mfma_f32_16x16x32_bf16(Bt[n][k], At[m][k], acc[ai][bj][m][n], 0, 0, 0); __builtin_amdgcn_s_setprio(0); } while (0)
#define PG8_WAIT_V(n) asm volatile("s_waitcnt vmcnt(" #n ")" ::: "memory")
#define PG8_WAIT_L(n) asm volatile("s_waitcnt lgkmcnt(" #n ")" ::: "memory")
#define PG8_BAR __builtin_amdgcn_s_barrier()
#define PG8_SCHED __builtin_amdgcn_sched_barrier(0)
    Unit cur, nxt; int ui = 0;
    if (!S.next(0, cur)) return;
    f32x4 acc[2][2][4][2];
#pragma unroll
    for (int a = 0; a < 2; ++a)
#pragma unroll
        for (int b = 0; b < 2; ++b)
#pragma unroll
            for (int m = 0; m < 4; ++m)
#pragma unroll
                for (int n = 0; n < 2; ++n) acc[a][b][m][n] = (f32x4){0.f, 0.f, 0.f, 0.f};
    bf16x8 At[4][2], B0[2][2], B1[2][2];
    const char* cA = (const char*)g.A + (size_t)cur.pm * tstep; const char* cB = (const char*)g.Bt + (size_t)cur.pn * tstep;
    S.a_ready(cur);
    if constexpr (SP2) {
        PG8_STAGE(PG8_SB(0, 0), cB, voffB); PG8_STAGE(PG8_SB(0, 1), cB + hstep, voffB); PG8_STAGE(PG8_SA(0, 0), cA, voffA); PG8_STAGE(PG8_SA(0, 1), cA + hstep, voffA);
        if (wr == 1) PG8_BAR;
        PG8_WAIT_V(2); PG8_BAR;
        PG8_STAGE(PG8_SB(1, 0), cB + kstep, voffB); PG8_STAGE(PG8_SA(1, 0), cA + kstep, voffA); PG8_STAGE(PG8_SB(1, 1), cB + hstep + kstep, voffB);
        PG8_WAIT_V(6); PG8_BAR;
    } else {
        PG8_STAGE(PG8_SB(0, 0), cB, voffB); PG8_STAGE(PG8_SA(0, 0), cA, voffA); PG8_STAGE(PG8_SB(0, 1), cB + hstep, voffB); PG8_STAGE(PG8_SA(0, 1), cA + hstep, voffA);
        if (wr == 1) PG8_BAR;
        PG8_WAIT_V(4); PG8_BAR;
        PG8_STAGE(PG8_SB(1, 0), cB + kstep, voffB); PG8_STAGE(PG8_SA(1, 0), cA + kstep, voffA); PG8_STAGE(PG8_SB(1, 1), cB + hstep + kstep, voffB);
        PG8_WAIT_V(6); PG8_BAR;
    }
    for (;;) {
        const bool has_next = S.next(ui + 1, nxt);
        const char* nA = has_next ? (const char*)g.A + (size_t)nxt.pm * tstep : cA; const char* nB = has_next ? (const char*)g.Bt + (size_t)nxt.pn * tstep : cB;
        for (int t = 0; t < nt; t += 2) {
            const bool last = (t == nt - 2);
            const char* a1 = cA + (size_t)(t + 1) * kstep;
            const char* a2 = last ? nA : cA + (size_t)(t + 2) * kstep; const char* b2 = last ? nB : cB + (size_t)(t + 2) * kstep;
            const char* a3 = a2 + kstep; const char* b3 = b2 + kstep;
            if (last && has_next) S.a_ready(nxt);
            if constexpr (SP2) {
            PG8_LDB(B0, 0, 0); PG8_LDB(B1, 0, 1); PG8_SCHED; PG8_LDA(At, 0, 0); PG8_STAGE(PG8_SA(1, 1), a1 + hstep, voffA);
            PG8_WAIT_V(8); PG8_WAIT_L(0); PG8_BAR; PG8_MMA(0, 0, At, B0); PG8_MMA(0, 1, At, B1); PG8_BAR; PG8_SCHED;
            PG8_LDA(At, 0, 1); PG8_STAGE(PG8_SB(0, 0), b2, voffB); PG8_STAGE(PG8_SB(0, 1), b2 + hstep, voffB); PG8_STAGE(PG8_SA(0, 0), a2, voffA);
            PG8_WAIT_V(8); PG8_WAIT_L(0); PG8_BAR; PG8_MMA(1, 0, At, B0); PG8_MMA(1, 1, At, B1); PG8_BAR; PG8_SCHED;
            PG8_LDB(B0, 1, 0); PG8_LDB(B1, 1, 1); PG8_SCHED; PG8_LDA(At, 1, 0); PG8_STAGE(PG8_SA(0, 1), a2 + hstep, voffA);
            PG8_WAIT_V(8); PG8_WAIT_L(0); PG8_BAR; PG8_MMA(0, 0, At, B0); PG8_MMA(0, 1, At, B1); PG8_BAR; PG8_SCHED;
            PG8_LDA(At, 1, 1); PG8_STAGE(PG8_SB(1, 0), b3, voffB); PG8_STAGE(PG8_SB(1, 1), b3 + hstep, voffB); PG8_STAGE(PG8_SA(1, 0), a3, voffA);
            PG8_WAIT_V(8); PG8_WAIT_L(0); PG8_BAR; PG8_MMA(1, 0, At, B0); PG8_MMA(1, 1, At, B1); PG8_BAR; PG8_SCHED;
            } else {
            PG8_LDB(B0, 0, 0); PG8_SCHED; PG8_LDA(At, 0, 0); PG8_STAGE(PG8_SA(1, 1), a1 + hstep, voffA);
            PG8_WAIT_L(8); PG8_BAR; PG8_WAIT_L(0); PG8_MMA(0, 0, At, B0); PG8_BAR; PG8_SCHED;
            PG8_LDB(B1, 0, 1); PG8_STAGE(PG8_SB(0, 0), b2, voffB);
            PG8_BAR; PG8_WAIT_L(0); PG8_MMA(0, 1, At, B1); PG8_BAR;
            PG8_LDA(At, 0, 1); PG8_STAGE(PG8_SA(0, 0), a2, voffA);
            PG8_BAR; PG8_WAIT_L(0); PG8_MMA(1, 0, At, B0); PG8_BAR; PG8_SCHED;
            PG8_STAGE(PG8_SB(0, 1), b2 + hstep, voffB);
            PG8_WAIT_V(6); PG8_BAR; PG8_MMA(1, 1, At, B1); PG8_BAR;
            PG8_LDB(B0, 1, 0); PG8_SCHED; PG8_LDA(At, 1, 0); PG8_STAGE(PG8_SA(0, 1), a2 + hstep, voffA);
            PG8_WAIT_L(8); PG8_BAR; PG8_WAIT_L(0); PG8_MMA(0, 0, At, B0); PG8_BAR; PG8_SCHED;
            PG8_LDB(B1, 1, 1); PG8_STAGE(PG8_SB(1, 0), b3, voffB);
            PG8_BAR; PG8_WAIT_L(0); PG8_MMA(0, 1, At, B1); PG8_BAR;
            PG8_LDA(At, 1, 1); PG8_STAGE(PG8_SA(1, 0), a3, voffA);
            PG8_BAR; PG8_WAIT_L(0); PG8_MMA(1, 0, At, B0); PG8_BAR; PG8_SCHED;
            PG8_STAGE(PG8_SB(1, 1), b3 + hstep, voffB);
            PG8_WAIT_V(6); PG8_BAR; PG8_MMA(1, 1, At, B1); PG8_BAR;
            }
        }
        if constexpr (ALIGN_EPI) { if (wr == 0) PG8_BAR; }
        if constexpr (!Epi::AFTER_DRAIN) { E(acc, cur, wr, wc, fr, fq); S.done(cur); }
        if (!has_next) break;
#pragma unroll
        for (int a = 0; a < 2; ++a)
#pragma unroll
            for (int b = 0; b < 2; ++b)
#pragma unroll
                for (int m = 0; m < 4; ++m)
#pragma unroll
                    for (int n = 0; n < 2; ++n) acc[a][b][m][n] = (f32x4){0.f, 0.f, 0.f, 0.f};
        cur = nxt; cA = nA; cB = nB; ++ui;
        if constexpr (ALIGN_EPI) { if (wr == 1) PG8_BAR; }
    }
    PG8_WAIT_V(0);
    if constexpr (!ALIGN_EPI) { if (wr == 0) PG8_BAR; }
    PG8_BAR;
    if constexpr (Epi::AFTER_DRAIN) { E.fused(acc, cur, wr, wc, fr, fq, lds, wid, lane); S.done(cur); }
#undef PG8_SA
#undef PG8_SB
#undef PG8_STAGE
#undef PG8_LDA
#undef PG8_LDB
#undef PG8_MMA
#undef PG8_WAIT_V
#undef PG8_WAIT_L
#undef PG8_BAR
#undef PG8_SCHED
}
}
#include <hip/hip_bf16.h>
#include <cmath>
namespace attn_body {
using bf16=__hip_bfloat16;
using bf16x8=__attribute__((ext_vector_type(8)))short;
using s16x4=__attribute__((ext_vector_type(4)))short;
using f32x16=__attribute__((ext_vector_type(16)))float;
using u32x4=__attribute__((ext_vector_type(4)))unsigned;
using f32x4v=__attribute__((ext_vector_type(4)))float;
constexpr int BATCH=4,NHEAD=4,SEQ=8192,D=64,DM=2560,DMO=256;
constexpr int NW=8,QBLK=32,QB=QBLK*NW,KVBLK=64,NQB=SEQ/QB;
constexpr int ATTN_PITCH=DM, ATTN_UNIT_ROWS=QB;
__device__ __forceinline__ int crow(int r,int hi){return (r&3)+8*(r>>2)+4*hi;}
#define SBAR() __builtin_amdgcn_sched_barrier(0)
__device__ __forceinline__ void cmask(f32x16&p0,f32x16&p1,int jb,int qrel,int hi){
  const float NEG=-INFINITY; int kb=64*jb+4*hi;
  #pragma unroll
  for(int r=0;r<16;++r){int kv=kb+(r&3)+8*(r>>2); if(kv>qrel)p0[r]=NEG; if(kv+32>qrel)p1[r]=NEG;}
}

constexpr int NSLOT=3, SLOTB=8192;
constexpr int LDS_K=0, LDS_V=NSLOT*SLOTB, LDS_WS=2*NSLOT*SLOTB, LDS_OST=LDS_WS+NW*64*4, LDS_AUX=LDS_OST+NW*4096, LDS_BYTES=LDS_AUX+32768;
constexpr float C2=0.125f*1.4426950408889634f;
__device__ __forceinline__ void glds16(const void*gsrc,unsigned lds_dst){unsigned keep;
  asm volatile("s_mov_b32 %0, m0\n\ts_mov_b32 m0, %2\n\ts_nop 0\n\tglobal_load_lds_dwordx4 %1, off\n\ts_mov_b32 m0, %0":"=&s"(keep):"v"(gsrc),"s"(lds_dst):"memory");}
__device__ __forceinline__ float max3f(float a,float b,float c){float r;asm("v_max3_f32 %0, %1, %2, %3":"=v"(r):"v"(a),"v"(b),"v"(c));return r;}
__device__ __forceinline__ float max2f(float a,float b){float r;asm("v_max_f32_e32 %0, %1, %2":"=v"(r):"v"(a),"v"(b));return r;}
__device__ __forceinline__ float fadd_s(float a,float b){float r;asm("v_add_f32_e32 %0, %1, %2":"=v"(r):"v"(a),"v"(b));return r;}
__device__ __forceinline__ float fsub_s(float a,float b){float r;asm("v_sub_f32_e32 %0, %1, %2":"=v"(r):"v"(a),"v"(b));return r;}
typedef float f32x2_t __attribute__((ext_vector_type(2))); typedef __bf16 bf16x2_t __attribute__((ext_vector_type(2)));
__device__ __forceinline__ unsigned cvtpk_s(float lo,float hi){f32x2_t v={lo,hi};bf16x2_t b=__builtin_convertvector(v,bf16x2_t);return __builtin_bit_cast(unsigned,b);}
#define WAIT_BAR(N) asm volatile("s_waitcnt vmcnt(" #N ") lgkmcnt(0)\n\ts_barrier":::"memory")

__device__ __forceinline__ void qkt(f32x16&p0,f32x16&p1,const char*Kslot,const bf16x8*qr,int r32,int hi){
  const char*kb=Kslot+hi*1024+r32*16;
  #pragma unroll
  for(int d0=0;d0<4;++d0){
    const bf16x8 b0=*reinterpret_cast<const bf16x8*>(kb+d0*2048);
    const bf16x8 b1=*reinterpret_cast<const bf16x8*>(kb+d0*2048+512);
    {p0=__builtin_amdgcn_mfma_f32_32x32x16_bf16(b0,qr[d0],p0,0,0,0);p1=__builtin_amdgcn_mfma_f32_32x32x16_bf16(b1,qr[d0],p1,0,0,0);}}
}
typedef __attribute__((address_space(3))) const char* lds_cptr;
typedef short v4i16_t __attribute__((ext_vector_type(4)));
__device__ __forceinline__ void kload8(bf16x8*kf,lds_cptr kp){
  kf[0]=*(const __attribute__((address_space(3))) bf16x8*)(kp);      kf[1]=*(const __attribute__((address_space(3))) bf16x8*)(kp+512);
  kf[2]=*(const __attribute__((address_space(3))) bf16x8*)(kp+2048); kf[3]=*(const __attribute__((address_space(3))) bf16x8*)(kp+2560);
  kf[4]=*(const __attribute__((address_space(3))) bf16x8*)(kp+4096); kf[5]=*(const __attribute__((address_space(3))) bf16x8*)(kp+4608);
  kf[6]=*(const __attribute__((address_space(3))) bf16x8*)(kp+6144); kf[7]=*(const __attribute__((address_space(3))) bf16x8*)(kp+6656);
}
__device__ __forceinline__ void kload2(bf16x8*kf,lds_cptr kp,int j){ kf[2*j]=*(const __attribute__((address_space(3))) bf16x8*)(kp+j*2048); kf[2*j+1]=*(const __attribute__((address_space(3))) bf16x8*)(kp+j*2048+512); }
__device__ __forceinline__ s16x4 vtr(lds_cptr p){ return __builtin_bit_cast(s16x4,__builtin_amdgcn_ds_read_tr16_b64_v4i16((__attribute__((address_space(3))) v4i16_t*)p)); }
__device__ __forceinline__ float rowmax(const f32x16&p0,const f32x16&p1){
  float a=max3f(p0[0],p0[1],p1[0]),b=max3f(p0[2],p0[3],p1[1]);a=max3f(a,p1[2],p1[3]);
  #pragma unroll
  for(int r=4;r<16;r+=4){a=max3f(a,p0[r],p0[r+1]);b=max3f(b,p0[r+2],p0[r+3]);a=max3f(a,p1[r],p1[r+1]);b=max3f(b,p1[r+2],p1[r+3]);}
  const float m=max2f(a,b);
  auto rr=__builtin_amdgcn_permlane32_swap(__float_as_uint(m),__float_as_uint(m),false,false);
  return max2f(__uint_as_float(rr[0]),__uint_as_float(rr[1]));
}
__device__ __forceinline__ void pv(f32x16*o,int vb,bf16x8 pa0,bf16x8 pa1,bf16x8 pa2,bf16x8 pa3){
  #pragma unroll
  for(int d0=0;d0<2;++d0){s16x4 lo[4],hi[4];
    #pragma unroll
    for(int ks=0;ks<4;++ks){
      asm volatile("ds_read_b64_tr_b16 %0,%1 offset:%c2":"=&v"(lo[ks]):"v"(vb),"i"(d0*4096+ks*1024):"memory");
      asm volatile("ds_read_b64_tr_b16 %0,%1 offset:%c2":"=&v"(hi[ks]):"v"(vb),"i"(d0*4096+ks*1024+512):"memory");}
    asm volatile("s_waitcnt lgkmcnt(0)":::"memory");SBAR();
    #define PK(k) (bf16x8){lo[k][0],lo[k][1],lo[k][2],lo[k][3],hi[k][0],hi[k][1],hi[k][2],hi[k][3]}
    o[d0]=__builtin_amdgcn_mfma_f32_32x32x16_bf16(pa0,PK(0),o[d0],0,0,0);
    o[d0]=__builtin_amdgcn_mfma_f32_32x32x16_bf16(pa1,PK(1),o[d0],0,0,0);
    o[d0]=__builtin_amdgcn_mfma_f32_32x32x16_bf16(pa2,PK(2),o[d0],0,0,0);
    o[d0]=__builtin_amdgcn_mfma_f32_32x32x16_bf16(pa3,PK(3),o[d0],0,0,0);
    #undef PK
  }
}

#ifndef ATTN_STORE16
#define ATTN_STORE16(p,v) (*(u32x4*)(p)=(v))
#endif
template<int THRL,int MODE> __device__ __forceinline__ void attn_unit(int b,int h,int qb,const bf16*Q,const bf16*__restrict__ K,const bf16*__restrict__ V,bf16*O,const float*__restrict__ aux,int t0,char*shm){
  int tid_=threadIdx.x; asm volatile("":"+v"(tid_));
  const int tid=tid_,lane=tid&63,r32=lane&31,hi=lane>>5; const int wid=__builtin_amdgcn_readfirstlane(tid>>6);
  const long rowbase=(long)b*SEQ; const int q0=qb*QB; const lds_cptr shm3=(lds_cptr)shm;
  const bf16*Qw=Q+(rowbase+q0+wid*QBLK)*DM+h*D;
  const bf16*Kh=K+rowbase*DM+h*D,*Vh=V+rowbase*DM+h*D;
  const unsigned lds0=(unsigned)(uintptr_t)shm;
  float*wsf=(float*)(shm+LDS_WS)+wid*64;
  const bf16*ksrc=Kh+(long)lane*DM+wid*8;
  const bf16*vsrc=Vh+(long)(16*(wid&3)+(lane>>2))*DM+(wid>>2)*32+(lane&3)*8;
  const unsigned kdst=lds0+LDS_K+wid*1024, vdst=lds0+LDS_V+wid*1024;
  #define DMA_K(t,slot) glds16(ksrc+(long)(t)*KVBLK*DM,(unsigned)__builtin_amdgcn_readfirstlane(kdst+(slot)))
  #define DMA_V(t,slot) glds16(vsrc+(long)(t)*KVBLK*DM,(unsigned)__builtin_amdgcn_readfirstlane(vdst+(slot)))
  const int vb0=(int)(lds0+LDS_V)+((lane>>4)&1)*32+(lane&3)*8+(4*hi+((lane&15)>>2))*64;
  const char*Kbase=shm+LDS_K; bf16x8 kf[8];
  const lds_cptr kp0=shm3+LDS_K+hi*1024+r32*16; const lds_cptr vp0=shm3+LDS_V+((lane>>4)&1)*32+(lane&3)*8+(4*hi+((lane&15)>>2))*64;
  const int NT=(q0+QB)/KVBLK;
  typedef __attribute__((address_space(3))) float lds_f32; typedef __attribute__((address_space(3))) f32x4v lds_f32x4;
  lds_f32* const auxl=(lds_f32*)(shm3+LDS_AUX);
  unsigned mbits=0u;
  if(MODE==0){
    const float*src=aux+(long)(b*NHEAD+h)*SEQ;
    for(int i=t0*KVBLK+tid*4;i<q0+QB;i+=NW*64*4) *(lds_f32x4*)(auxl+i)=*(const f32x4v*)(src+i);
    asm volatile("s_waitcnt vmcnt(0) lgkmcnt(0)\n\ts_barrier":::"memory");
  } else {
    const float*src=aux+(long)(b*NHEAD+h)*(NQB*D);
    *(lds_f32x4*)(auxl+tid*4)=*(const f32x4v*)(src+tid*4);
    asm volatile("s_waitcnt vmcnt(0) lgkmcnt(0)\n\ts_barrier":::"memory");
    float qf[32];
    #pragma unroll
    for(int d0=0;d0<4;++d0){ const bf16x8 qv=*reinterpret_cast<const bf16x8*>(&Qw[(long)r32*DM+d0*16+hi*8]);
      #pragma unroll
      for(int j=0;j<8;++j) qf[d0*8+j]=__uint_as_float(((unsigned)(unsigned short)qv[j])<<16); }
    float b1=-INFINITY,b2=-INFINITY,b3=-INFINITY; int i1=-1,i2=-1,i3=-1;
    for(int n=0;n<qb;++n){ const lds_f32* kb=auxl+n*D+hi*8; float sa=0.f,sb=0.f;
      #pragma unroll
      for(int d0=0;d0<4;++d0){ const f32x4v ka=*(const lds_f32x4*)(kb+d0*16), kc=*(const lds_f32x4*)(kb+d0*16+4);
        sa+=qf[d0*8+0]*ka.x; sb+=qf[d0*8+1]*ka.y; sa+=qf[d0*8+2]*ka.z; sb+=qf[d0*8+3]*ka.w;
        sa+=qf[d0*8+4]*kc.x; sb+=qf[d0*8+5]*kc.y; sa+=qf[d0*8+6]*kc.z; sb+=qf[d0*8+7]*kc.w; }
      float s=sa+sb; s+=__shfl_xor(s,32);
      if(s>b1){b3=b2;i3=i2;b2=b1;i2=i1;b1=s;i1=n;} else if(s>b2){b3=b2;i3=i2;b2=s;i2=n;} else if(s>b3){b3=s;i3=n;} }
    mbits=(i1>=0?(1u<<i1):0u)|(i2>=0?(1u<<i2):0u)|(i3>=0?(1u<<i3):0u);
  }
  #define INITC(P0,P1,t) do{ if(MODE==0){ const lds_f32* bp_=auxl+(t)*KVBLK+4*hi; \
      _Pragma("unroll") for(int g_=0;g_<4;++g_){ const f32x4v a_=*(const lds_f32x4*)(bp_+8*g_), c_=*(const lds_f32x4*)(bp_+32+8*g_); \
        P0[4*g_]=a_.x-mhat;P0[4*g_+1]=a_.y-mhat;P0[4*g_+2]=a_.z-mhat;P0[4*g_+3]=a_.w-mhat; P1[4*g_]=c_.x-mhat;P1[4*g_+1]=c_.y-mhat;P1[4*g_+2]=c_.z-mhat;P1[4*g_+3]=c_.w-mhat; } } \
    else { const float nm_=((t)>=NT-4||((mbits>>((t)>>2))&1u))?-mhat:-INFINITY; \
      _Pragma("unroll") for(int r=0;r<16;++r){P0[r]=nm_;P1[r]=nm_;} asm volatile("":"+v"(P0),"+v"(P1)); } }while(0)
  DMA_K(t0,0);DMA_V(t0,0);DMA_K(t0+1,SLOTB);
  bf16x8 qr[4];
  #pragma unroll
  for(int d0=0;d0<4;++d0)qr[d0]=*reinterpret_cast<const bf16x8*>(&Qw[(long)r32*DM+d0*16+hi*8]);
  float mhat=0.f,l_reg=0.f;f32x16 o[2];o[0]=f32x16{};o[1]=f32x16{};
  const int qrel=wid*QBLK+r32;
  #define CMASK(P0,P1,t) do{int jb_=(t)-(NT-4); if(jb_>=0)cmask(P0,P1,jb_,qrel,hi);}while(0)
  bool resc=false;
  #define START(P0,P1) do{ const float rm=rowmax(P0,P1); resc=false; \
    { const float dl=(rm==-INFINITY)?0.f:rm; mhat=fadd_s(mhat,dl); \
      _Pragma("unroll") for(int r=0;r<16;++r){P0[r]=fsub_s(P0[r],dl);P1[r]=fsub_s(P1[r],dl);} \
      } \
    _Pragma("unroll") for(int r=0;r<16;++r)P0[r]=__builtin_amdgcn_exp2f(P0[r]); }while(0)
  #define RESC() do{ if(resc){ asm volatile("s_waitcnt lgkmcnt(0)":::"memory"); \
      _Pragma("unroll") for(int d_=0;d_<2;++d_) _Pragma("unroll") for(int r=0;r<16;++r)o[d_][r]*=wsf[crow(r,hi)]; } }while(0)
  f32x16 pA0,pA1,pB0,pB1;
  int sl_prev=0,sl_cur=0,sl_next=SLOTB;
  #define ROT() do{sl_prev=sl_cur;sl_cur=sl_next;sl_next=(sl_next==(NSLOT-1)*SLOTB)?0:sl_next+SLOTB;}while(0)
  DMA_K(t0+2,2*SLOTB);
  WAIT_BAR(3);
  INITC(pA0,pA1,t0);qkt(pA0,pA1,Kbase,qr,r32,hi);asm volatile("s_nop 15\n\ts_nop 7":"+v"(pA0),"+v"(pA1));CMASK(pA0,pA1,t0);
  START(pA0,pA1);
  _Pragma("unroll") for(int r=0;r<16;++r)pA1[r]=__builtin_amdgcn_exp2f(pA1[r]);
  WAIT_BAR(0);
  DMA_K(t0+3,0);DMA_V(t0+1,SLOTB);
  ROT();
  kload8(kf,kp0+sl_cur);
  WAIT_BAR(2);
  s16x4 vlo[8],vhi[8]; u32x4 pw0,pw1,pw2,pw3;
  #define PKW(P,B) cvtpk_s(P[B],P[B+1])
  #define PAF(k) __builtin_bit_cast(bf16x8,pw##k)
  #define VFR(i) (bf16x8){vlo[i][0],vlo[i][1],vlo[i][2],vlo[i][3],vhi[i][0],vhi[i][1],vhi[i][2],vhi[i][3]}
  #define PIN(x) asm volatile("":"+v"(x))
  #define MX3(a,b,c) __builtin_fmaxf(__builtin_fmaxf((a),(b)),(c))
  #define GAPA(MF,A0,A1,A2,A3,W0,W1,PW) do{ MF; sacc+=A0; sacc+=A1; sacc+=A2; sacc+=A3; PIN(sacc); W0; W1; PIN(PW); SBAR(); }while(0)
  #define EX(v) __builtin_amdgcn_exp2f(v)
  #define GAPB(MF,X,B) do{ MF; X[B]=EX(X[B]); X[B+1]=EX(X[B+1]); X[B+2]=EX(X[B+2]); X[B+3]=EX(X[B+3]); PIN(X); SBAR(); }while(0)
  #define VRD(i) do{ vlo[i]=vtr(vp_+(((i)>>2)*4096+((i)&3)*1024)); vhi[i]=vtr(vp_+(((i)>>2)*4096+((i)&3)*1024+512)); }while(0)
  #define KRD(G,j) do{ if(G){ kload2(kf,kp0+sl_next,j); SBAR(); } }while(0)
  #define STEP(C0,C1,P0,P1,t,GK,GV,GL) do{ SBAR(); INITC(C0,C1,t); SBAR(); \
    const lds_cptr vp_=vp0+sl_prev; \
    VRD(0); SBAR(); float sacc=(P0[0]+P0[1]); \
    GAPA(C0=__builtin_amdgcn_mfma_f32_32x32x16_bf16(kf[0],qr[0],C0,0,0,0), P0[2],P0[3],P0[4],P0[5],     pw0[0]=PKW(P0,0), pw0[1]=PKW(P0,2), pw0); \
    VRD(4); SBAR(); GAPA(C1=__builtin_amdgcn_mfma_f32_32x32x16_bf16(kf[1],qr[0],C1,0,0,0), P0[6],P0[7],P0[8],P0[9],     pw0[2]=PKW(P0,4), pw0[3]=PKW(P0,6), pw0); \
    VRD(1); SBAR(); GAPA(C0=__builtin_amdgcn_mfma_f32_32x32x16_bf16(kf[2],qr[1],C0,0,0,0),   P0[10],P0[11],P0[12],P0[13], pw1[0]=PKW(P0,8), pw1[1]=PKW(P0,10), pw1); \
    VRD(5); SBAR(); GAPA(C1=__builtin_amdgcn_mfma_f32_32x32x16_bf16(kf[3],qr[1],C1,0,0,0),   P0[14],P0[15],P1[0],P1[1],   pw1[2]=PKW(P0,12),pw1[3]=PKW(P0,14), pw1); \
    VRD(2); SBAR(); GAPA(C0=__builtin_amdgcn_mfma_f32_32x32x16_bf16(kf[4],qr[2],C0,0,0,0),   P1[2],P1[3],P1[4],P1[5],     pw2[0]=PKW(P1,0), pw2[1]=PKW(P1,2), pw2); \
    VRD(6); SBAR(); GAPA(C1=__builtin_amdgcn_mfma_f32_32x32x16_bf16(kf[5],qr[2],C1,0,0,0),   P1[6],P1[7],P1[8],P1[9],     pw2[2]=PKW(P1,4), pw2[3]=PKW(P1,6), pw2); \
    VRD(3); SBAR(); GAPA(C0=__builtin_amdgcn_mfma_f32_32x32x16_bf16(kf[6],qr[3],C0,0,0,0),   P1[10],P1[11],P1[12],P1[13], pw3[0]=PKW(P1,8), pw3[1]=PKW(P1,10), pw3); \
    VRD(7); SBAR(); GAPA(C1=__builtin_amdgcn_mfma_f32_32x32x16_bf16(kf[7],qr[3],C1,0,0,0),   P1[14],P1[15],0.f,0.f,       pw3[2]=PKW(P1,12),pw3[3]=PKW(P1,14), pw3); \
    l_reg+=sacc; \
    if(GK){DMA_K((t)+3,sl_cur);} if(GV){DMA_V((t)+1,sl_next);} \
    CMASK(C0,C1,t); \
    { float a=MX3(C0[0],C0[1],C1[0]),b=MX3(C0[2],C0[3],C1[1]); a=MX3(a,C1[2],C1[3]); \
      _Pragma("unroll") for(int r=4;r<16;r+=4){a=MX3(a,C0[r],C0[r+1]);b=MX3(b,C0[r+2],C0[r+3]);a=MX3(a,C1[r],C1[r+1]);b=MX3(b,C1[r+2],C1[r+3]);} \
      float rm=__builtin_fmaxf(a,b); { auto rr=__builtin_amdgcn_permlane32_swap(__float_as_uint(rm),__float_as_uint(rm),false,false); rm=__builtin_fmaxf(__uint_as_float(rr[0]),__uint_as_float(rr[1])); } \
      resc=false; \
      if(__builtin_expect(__any(rm>(float)THRL),0)){ const float dl=__builtin_fmaxf(rm,0.f); mhat+=dl; \
        _Pragma("unroll") for(int r=0;r<16;++r){C0[r]-=dl;C1[r]-=dl;} \
        const float f=__builtin_amdgcn_exp2f(-dl); l_reg*=f; if(hi==0)wsf[r32]=f; resc=true; } } \
    SBAR(); \
    GAPB(o[0]=__builtin_amdgcn_mfma_f32_32x32x16_bf16(PAF(0),VFR(0),o[0],0,0,0), C0,0); \
    GAPB(o[1]=__builtin_amdgcn_mfma_f32_32x32x16_bf16(PAF(0),VFR(4),o[1],0,0,0), C0,4); \
    KRD(GL,0); GAPB(o[0]=__builtin_amdgcn_mfma_f32_32x32x16_bf16(PAF(1),VFR(1),o[0],0,0,0), C0,8); \
    KRD(GL,1); GAPB(o[1]=__builtin_amdgcn_mfma_f32_32x32x16_bf16(PAF(1),VFR(5),o[1],0,0,0), C0,12); \
    KRD(GL,2); GAPB(o[0]=__builtin_amdgcn_mfma_f32_32x32x16_bf16(PAF(2),VFR(2),o[0],0,0,0), C1,0); \
    KRD(GL,3); GAPB(o[1]=__builtin_amdgcn_mfma_f32_32x32x16_bf16(PAF(2),VFR(6),o[1],0,0,0), C1,4); \
    GAPB(o[0]=__builtin_amdgcn_mfma_f32_32x32x16_bf16(PAF(3),VFR(3),o[0],0,0,0), C1,8); \
    GAPB(o[1]=__builtin_amdgcn_mfma_f32_32x32x16_bf16(PAF(3),VFR(7),o[1],0,0,0), C1,12); \
    }while(0)
  int t=t0+1;
  #undef CMASK
  #define CMASK(P0,P1,t) do{}while(0)
  for(;t+5<NT;t+=2){
    STEP(pB0,pB1,pA0,pA1,t,true,true,true);     WAIT_BAR(2); RESC(); ROT();
    STEP(pA0,pA1,pB0,pB1,t+1,true,true,true);   WAIT_BAR(2); RESC(); ROT();
  }
  #undef CMASK
  #define CMASK(P0,P1,t) do{int jb_=(t)-(NT-4); if(jb_>=0)cmask(P0,P1,jb_,qrel,hi);}while(0)
  #define ENDW(tt) do{ if((tt)+3<NT){WAIT_BAR(2);} else if((tt)+2<NT){WAIT_BAR(1);} else {WAIT_BAR(0);} }while(0)
  for(;t+1<NT;t+=2){
    STEP(pB0,pB1,pA0,pA1,t,(t+3<NT),(t+1<NT),(t+1<NT));       ENDW(t);   RESC(); ROT();
    STEP(pA0,pA1,pB0,pB1,t+1,(t+4<NT),(t+2<NT),(t+2<NT));     ENDW(t+1); RESC(); ROT();
  }
  STEP(pB0,pB1,pA0,pA1,NT-1,false,false,false); RESC();
  { float sacc=pB0[0]+pB0[1]; _Pragma("unroll") for(int r=2;r<16;++r)sacc+=pB0[r]; _Pragma("unroll") for(int r=0;r<16;++r)sacc+=pB1[r]; l_reg+=sacc;
    pw0=(u32x4){PKW(pB0,0),PKW(pB0,2),PKW(pB0,4),PKW(pB0,6)};pw1=(u32x4){PKW(pB0,8),PKW(pB0,10),PKW(pB0,12),PKW(pB0,14)};pw2=(u32x4){PKW(pB1,0),PKW(pB1,2),PKW(pB1,4),PKW(pB1,6)};pw3=(u32x4){PKW(pB1,8),PKW(pB1,10),PKW(pB1,12),PKW(pB1,14)};
    SBAR(); pv(o,vb0+sl_cur,PAF(0),PAF(1),PAF(2),PAF(3)); }
  #undef PKW
  #undef PAF
  #undef VFR
  #undef PIN
  #undef MX3
  #undef GAPA
  #undef GAPB
  #undef EX
  #undef VRD
  #undef KRD
  #undef STEP
  #undef ENDW
  {auto rr=__builtin_amdgcn_permlane32_swap(__float_as_uint(l_reg),__float_as_uint(l_reg),false,false);l_reg=__uint_as_float(rr[0])+__uint_as_float(rr[1]);}
  if(hi==0)wsf[32+r32]=l_reg;asm volatile("s_waitcnt lgkmcnt(0)":::"memory");
  float rli[16];
  #pragma unroll
  for(int r=0;r<16;++r)rli[r]=__builtin_amdgcn_rcpf(wsf[32+crow(r,hi)]);
  bf16*Ow=O+(rowbase+q0+wid*QBLK)*DMO+h*D;
  { bf16*stg=(bf16*)(shm+LDS_OST)+wid*2048;
    #pragma unroll
    for(int r=0;r<16;++r){const int orow=crow(r,hi);
      #pragma unroll
      for(int d0=0;d0<2;++d0)stg[orow*64+d0*32+r32]=__float2bfloat16(o[d0][r]*rli[r]);}
    asm volatile("s_waitcnt lgkmcnt(0)":::"memory");
    #pragma unroll
    for(int i=0;i<4;++i){const int row=i*8+(lane>>3),ch=lane&7; const u32x4 v=*(const u32x4*)(stg+row*64+ch*8); ATTN_STORE16(Ow+(long)row*DMO+ch*8,v);} }
  asm volatile("s_waitcnt lgkmcnt(0)\n\ts_barrier":::"memory");
  #undef INITC
  #undef DMA_K
  #undef DMA_V
  #undef CMASK
  #undef START
  #undef RESC
  #undef ROT
}
constexpr int ATTN_LDS_BYTES=LDS_BYTES;
struct AttnTensors { const bf16* P; bf16* Y; const float* kbias; const float* kbar; const float* nrm; };
__device__ __forceinline__ int fox_first_tile(const float* kbias_bh, const float* nrm_bh, int qb, int lane){
  const float qn=nrm_bh[2*qb]; float kn=0.f;
  for(int n=0;n<=qb;++n) kn=fmaxf(kn,nrm_bh[2*n+1]);
  const float thr=kbias_bh[qb*QB]-(2.0f*sqrtf(qn*kn)+160.0f);
  const int NT=(qb*QB+QB)/KVBLK; int first=NT;
  for(int base=0;base<NT;base+=64){ const int t=base+lane; const bool c=(t<NT)&&(kbias_bh[t*KVBLK+KVBLK-1]>thr);
    const unsigned long long m=__ballot(c); if(m){ first=base+__builtin_ctzll(m); break; } }
  first&=~1; if(first>NT-4)first=NT-4; return first;
}
template<int THRL=8> __device__ __forceinline__ void attn_phase(char*lds,const AttnTensors&T,int vcu,int G){
  for(int vc=vcu;vc<256;vc+=G){ const int s=vc&15, bh=vc>>4, b=bh>>2, h=bh&3;
    for(int i=0;i<4;++i){ const int qb=(i&1)?s:31-s;
#ifndef NO_MOBA
      if(i<2) attn_unit<THRL,1>(b,h,qb,T.P+1024,T.P+1280,T.P+1536,T.Y+(long)2*BATCH*SEQ*DMO,T.kbar,0,lds);
#endif
#ifndef NO_FOX
      if(i>=2){ int l_=threadIdx.x; asm volatile("":"+v"(l_)); const int t0=fox_first_tile(T.kbias+(long)bh*SEQ,T.nrm+(long)bh*NQB*2,qb,l_&63);
        attn_unit<THRL,0>(b,h,qb,T.P+1792,T.P+2048,T.P+2304,T.Y+(long)3*BATCH*SEQ*DMO,T.kbias,__builtin_amdgcn_readfirstlane(t0),lds); }
#endif
    } }
}
#undef SBAR
#undef WAIT_BAR
}
constexpr int NWAVES = 8;
constexpr int BATCH = 4, SEQ = 8192, T = BATCH * SEQ, D = 1024, FF = 4096, DEPTH = 4, INW = 6660, NA = 2560, NG = 4096, FCOL = 2560, GCOL = 2564;
constexpr float LN_EPS = 1e-5f, ALPHA = 1.681792830507429f;
constexpr size_t MiB = 1u << 20;
constexpr size_t WS_ADA = 0, WS_KBIAS = 512 * 1024, WS_LOGF = 1 * MiB, WS_KBAR = 1 * MiB + 512 * 1024, WS_ROPE = 2 * MiB;
constexpr size_t WS_WINA = 4 * MiB, WS_WG = 9 * MiB, WS_WB = 17 * MiB, WS_WO = 19 * MiB, WS_WUP = 21 * MiB, WS_WDN = 29 * MiB;
constexpr size_t WS_STATS = 38 * MiB;
constexpr size_t WS_Y = 40 * MiB;
constexpr size_t WS_U = 104 * MiB;
constexpr size_t WS_YB = 168 * MiB;
constexpr size_t WS_U8 = 456 * MiB;
constexpr size_t WS_R1 = 232 * MiB;
constexpr size_t WS_END = 488 * MiB;
constexpr size_t WS_NRM = 1 * MiB + 512 * 1024 + 192 * 1024;
constexpr size_t WS_BAR = 1 * MiB + 768 * 1024, BAR_ZERO_BYTES = 16384;
constexpr int RING_BYTES = 131072, LDS_BYTES = 147456;
typedef unsigned short bf16;
typedef float f32x4 __attribute__((ext_vector_type(4)));
typedef unsigned v4u __attribute__((ext_vector_type(4)));
typedef unsigned v2u __attribute__((ext_vector_type(2)));
__device__ __forceinline__ unsigned f2bf(float f) { unsigned u = __builtin_bit_cast(unsigned, f); return (u + 0x7fffu + ((u >> 16) & 1u)) >> 16; }
__device__ __forceinline__ unsigned pk2(float lo, float hi) { return pg8::cvt_pk_bf16(lo, hi); }
__device__ __forceinline__ float bflo(unsigned w) { return __uint_as_float(w << 16); }
__device__ __forceinline__ float bfhi(unsigned w) { return __uint_as_float(w & 0xffff0000u); }
__device__ __forceinline__ float wave_sum(float v) {
#pragma unroll
    for (int o = 1; o < 64; o <<= 1) v += __shfl_xor(v, o);
    return v;
}
struct Args {
    const float *x, *c; const int* pos; const float *w_ada, *b_ada, *w_in, *b_in, *w_pool, *pool_scale, *conv_w, *w_branch, *w_o, *ln1_g, *ln1_b, *w_up, *b_up, *w_down, *ln2_g, *ln2_b;
    float* out; unsigned char* ws;
};
struct Frame { unsigned char* lds; int tid, lane, wave, vcu, G; };

__device__ __forceinline__ void transpose_item(const float* W, int K, int N, int ldw, bf16* WT, float* scr, int item, int lane) {
    const int nblk = N / 32, kb = item / nblk, nb = item % nblk, k0 = 64 * kb, n0 = 32 * nb;
#pragma unroll 8
    for (int i = 0; i < 32; ++i) { const int kk = 2 * i + (lane >> 5); scr[kk * 33 + (lane & 31)] = W[(size_t)(k0 + kk) * ldw + n0 + (lane & 31)]; }
    asm volatile("s_waitcnt lgkmcnt(0)" ::: "memory");
    const int c = lane & 7;
#pragma unroll
    for (int j = 0; j < 4; ++j) { const int n = (lane >> 3) + 8 * j; const float* s = scr + (8 * c) * 33 + n;
        v4u o; o.x = pk2(s[0 * 33], s[1 * 33]); o.y = pk2(s[2 * 33], s[3 * 33]); o.z = pk2(s[4 * 33], s[5 * 33]); o.w = pk2(s[6 * 33], s[7 * 33]);
        *(v4u*)(WT + (size_t)(n0 + n) * K + k0 + 8 * c) = o; }
    asm volatile("s_waitcnt lgkmcnt(0)" ::: "memory");
}
__device__ __forceinline__ void transpose_item8(const float* W, int K, int N, int ldw, unsigned char* WT, float* scr, int item, int lane, float scale) {
    const int nblk = N / 32, kb = item / nblk, nb = item % nblk, k0 = 64 * kb, n0 = 32 * nb;
#pragma unroll 8
    for (int i = 0; i < 32; ++i) { const int kk = 2 * i + (lane >> 5); scr[kk * 33 + (lane & 31)] = W[(size_t)(k0 + kk) * ldw + n0 + (lane & 31)] * scale; }
    asm volatile("s_waitcnt lgkmcnt(0)" ::: "memory");
    const int c = lane & 7;
#pragma unroll
    for (int j = 0; j < 4; ++j) { const int n = (lane >> 3) + 8 * j; const float* s = scr + (8 * c) * 33 + n;
        int w0 = __builtin_amdgcn_cvt_pk_fp8_f32(s[0 * 33], s[1 * 33], 0, false); w0 = __builtin_amdgcn_cvt_pk_fp8_f32(s[2 * 33], s[3 * 33], w0, true);
        int w1 = __builtin_amdgcn_cvt_pk_fp8_f32(s[4 * 33], s[5 * 33], 0, false); w1 = __builtin_amdgcn_cvt_pk_fp8_f32(s[6 * 33], s[7 * 33], w1, true);
        v2u o; o.x = (unsigned)w0; o.y = (unsigned)w1;
        *(v2u*)(WT + (size_t)(n0 + n) * K + k0 + 8 * c) = o; }
    asm volatile("s_waitcnt lgkmcnt(0)" ::: "memory");
}
__device__ __forceinline__ void convert_weights(const Frame& F, const Args& a, int l) {
    float* scr = (float*)(F.lds + F.wave * 16384);
    const int gw = F.vcu * NWAVES + F.wave, NGW = F.G * NWAVES;
    constexpr int I_A = (D / 64) * (NA / 32), I_G = (D / 64) * (NG / 32), I_B = (256 / 64) * (D / 32), I_O = (D / 64) * (D / 32), I_U = (D / 64) * (FF / 32), I_D = (FF / 64) * (D / 32);
    constexpr int NITEMS = I_A + I_G + 4 * I_B + I_O + I_U + I_D;
    const float* win = a.w_in + (size_t)l * D * INW;
    for (int it = gw; it < NITEMS; it += NGW) {
        int r = it;
        if (r < I_A) { transpose_item(win, D, NA, INW, (bf16*)(a.ws + WS_WINA), scr, r, F.lane); continue; } r -= I_A;
        if (r < I_G) { transpose_item(win + GCOL, D, NG, INW, (bf16*)(a.ws + WS_WG), scr, r, F.lane); continue; } r -= I_G;
        if (r < 4 * I_B) { const int n = r / I_B; transpose_item(a.w_branch + ((size_t)l * 4 + n) * 256 * D, 256, D, D, (bf16*)(a.ws + WS_WB) + (size_t)n * D * 256, scr, r % I_B, F.lane); continue; } r -= 4 * I_B;
        if (r < I_O) { transpose_item(a.w_o + (size_t)l * D * D, D, D, D, (bf16*)(a.ws + WS_WO), scr, r, F.lane); continue; } r -= I_O;
        if (r < I_U) { transpose_item(a.w_up + (size_t)l * D * FF, D, FF, FF, (bf16*)(a.ws + WS_WUP), scr, r, F.lane); continue; } r -= I_U;
        transpose_item(a.w_down + (size_t)l * FF * D, FF, D, D, (bf16*)(a.ws + WS_WDN), scr, r, F.lane);
    }
}
__device__ __forceinline__ void sincos_f64(double x, float& sn, float& cs) {
    const double n = rint(x * 0.15915494309189535); double r = x - n * 6.283185307179586;
    const double k = rint(r * 0.6366197723675814); const double y = r - k * 1.5707963267948966;
    const double y2 = y * y;
    const double s = y * (1.0 + y2 * (-1.0 / 6 + y2 * (1.0 / 120 + y2 * (-1.0 / 5040 + y2 * (1.0 / 362880 + y2 * (-1.0 / 39916800 + y2 * (1.0 / 6227020800.0)))))));
    const double c = 1.0 + y2 * (-0.5 + y2 * (1.0 / 24 + y2 * (-1.0 / 720 + y2 * (1.0 / 40320 + y2 * (-1.0 / 3628800 + y2 * (1.0 / 479001600.0 + y2 * (-1.0 / 87178291200.0)))))));
    const int q = ((int)k) & 3;
    const double sr = (q == 0) ? s : (q == 1) ? c : (q == 2) ? -s : -c;
    const double cr = (q == 0) ? c : (q == 1) ? -s : (q == 2) ? -c : s;
    sn = (float)sr; cs = (float)cr;
}
__device__ __forceinline__ void phase_ada(const Frame& F, const Args& a) {
    float* sc = (float*)F.lds;
    if (blockIdx.x < 192) {
        for (int i = F.tid; i < BATCH * D; i += NWAVES * 64) { const float cv = a.c[i]; sc[i] = cv / (1.0f + __builtin_amdgcn_exp2f(-1.4426950408889634f * cv)); }
        __syncthreads();
        const int j = blockIdx.x, l = j / 48, colbase = (j % 48) * 128, cc = F.tid & 127, kq = F.tid >> 7;
        const float* w = a.w_ada + ((size_t)l * D + kq * 256) * (6 * D) + colbase + cc;
        const float* s0 = sc + kq * 256;
        float a0 = 0.f, a1 = 0.f, a2 = 0.f, a3 = 0.f;
#pragma unroll 32
        for (int k = 0; k < 256; ++k) { const float wv = w[(size_t)k * (6 * D)]; a0 += s0[k] * wv; a1 += s0[D + k] * wv; a2 += s0[2 * D + k] * wv; a3 += s0[3 * D + k] * wv; }
        float* red = sc + BATCH * D;
        red[(kq * 4 + 0) * 128 + cc] = a0; red[(kq * 4 + 1) * 128 + cc] = a1; red[(kq * 4 + 2) * 128 + cc] = a2; red[(kq * 4 + 3) * 128 + cc] = a3;
        __syncthreads();
        { const int b = F.tid >> 7; const float v = red[(0 * 4 + b) * 128 + cc] + red[(1 * 4 + b) * 128 + cc] + red[(2 * 4 + b) * 128 + cc] + red[(3 * 4 + b) * 128 + cc] + a.b_ada[l * 6 * D + colbase + cc];
          ((float*)(a.ws + WS_ADA))[(size_t)(l * BATCH + b) * 6 * D + colbase + cc] = v; }
        __syncthreads();
    }
    { const int gt = blockIdx.x * (NWAVES * 64) + F.tid, GT = F.G * NWAVES * 64; float* rope = (float*)(a.ws + WS_ROPE);
      for (int idx = gt; idx < T * 8; idx += GT) { const int t = idx >> 3, i = idx & 7;
          const float inv = (i == 0) ? 1.0f : (i == 1) ? 0.1939227432012558f : (i == 2) ? 0.03760603070259094f : (i == 3) ? 0.007292664609849453f : (i == 4) ? 0.0014142135623842478f : (i == 5) ? 0.00027424818836152554f : (i == 6) ? 5.318296098266728e-05f : 1.0313386155758053e-05f;
          const float ang = (float)a.pos[t] * inv; float sn, cs; sincos_f64((double)ang, sn, cs);
          rope[(size_t)t * 16 + i] = cs; rope[(size_t)t * 16 + 8 + i] = sn; } }
    convert_weights(F, a, 0);
}
__device__ __forceinline__ void phase_ln(const Frame& F, const Args& a, const float* in, float* xout, const float* lng, const float* lnb, const float* ada_sh, const float* ada_sc, bf16* U, int wf_l, float* stats_out = nullptr, const bf16* in16 = nullptr, unsigned char* U8 = nullptr) {
    float* wf = (float*)F.lds;
    if (wf_l >= 0) { const float* src = a.w_in + (size_t)wf_l * D * INW + FCOL;
        for (int i = F.tid; i < D; i += NWAVES * 64) *(f32x4*)(wf + 4 * i) = *(const f32x4*)(src + (size_t)i * INW);
        __syncthreads(); }
    const int gw = F.vcu * NWAVES + F.wave, NGW = F.G * NWAVES;
    if (stats_out && gw == 0) {
#pragma unroll
        for (int j = 0; j < 4; ++j) { *((f32x4*)(stats_out + 2 * T) + F.lane + 64 * j) = *((const f32x4*)lng + F.lane + 64 * j) * ALPHA; *((f32x4*)(stats_out + 2 * T + D) + F.lane + 64 * j) = *((const f32x4*)lnb + F.lane + 64 * j) * ALPHA; } }
    for (int m0 = gw; m0 < T; m0 += 2 * NGW) {
        f32x4 vv[2][4];
#pragma unroll
        for (int h = 0; h < 2; ++h) { const int m = m0 + h * NGW; if (m < T) {
            if (in16) { const v2u* xr = (const v2u*)(in16 + (size_t)m * D) + F.lane;
#pragma unroll
                for (int j = 0; j < 4; ++j) { const v2u q = xr[64 * j]; vv[h][j] = (f32x4){bflo(q.x), bfhi(q.x), bflo(q.y), bfhi(q.y)}; } }
            else { const f32x4* xr = (const f32x4*)(in + (size_t)m * D) + F.lane;
#pragma unroll
                for (int j = 0; j < 4; ++j) vv[h][j] = xr[64 * j]; } } }
#pragma unroll
        for (int h = 0; h < 2; ++h) { const int m = m0 + h * NGW; if (m >= T) break;
        f32x4 v[4];
#pragma unroll
        for (int j = 0; j < 4; ++j) v[j] = vv[h][j];
        if (lng) {
            float s = 0.f;
#pragma unroll
            for (int j = 0; j < 4; ++j) s += (v[j].x + v[j].y) + (v[j].z + v[j].w);
            const float mean = wave_sum(s) * (1.f / D); float s2 = 0.f;
#pragma unroll
            for (int j = 0; j < 4; ++j) { v[j] = v[j] - mean; s2 += (v[j].x * v[j].x + v[j].y * v[j].y) + (v[j].z * v[j].z + v[j].w * v[j].w); }
            const float rstd = 1.f / sqrtf(wave_sum(s2) * (1.f / D) + LN_EPS);
            if (stats_out && F.lane == 0) { stats_out[2 * (size_t)m] = mean; stats_out[2 * (size_t)m + 1] = rstd; }
#pragma unroll
            for (int j = 0; j < 4; ++j) { const f32x4 g = *((const f32x4*)lng + F.lane + 64 * j), bb = *((const f32x4*)lnb + F.lane + 64 * j); v[j] = v[j] * rstd * g + bb; }
            if (xout) { f32x4* xo = (f32x4*)(xout + (size_t)m * D) + F.lane;
#pragma unroll
                for (int j = 0; j < 4; ++j) xo[64 * j] = v[j]; }
        }
        if (U) {
            const int b = m >> 13;
            float s = 0.f;
#pragma unroll
            for (int j = 0; j < 4; ++j) s += (v[j].x + v[j].y) + (v[j].z + v[j].w);
            const float mean = wave_sum(s) * (1.f / D); float s2 = 0.f;
#pragma unroll
            for (int j = 0; j < 4; ++j) { v[j] = v[j] - mean; s2 += (v[j].x * v[j].x + v[j].y * v[j].y) + (v[j].z * v[j].z + v[j].w * v[j].w); }
            const float rstd = 1.f / sqrtf(wave_sum(s2) * (1.f / D) + LN_EPS);
            const f32x4* scp = (const f32x4*)(ada_sc + (size_t)b * 6 * D) + F.lane; const f32x4* shp = (const f32x4*)(ada_sh + (size_t)b * 6 * D) + F.lane;
            unsigned long long* o8 = (unsigned long long*)(U + (size_t)m * D) + F.lane;
            f32x4 fa = (f32x4){0.f, 0.f, 0.f, 0.f};
#pragma unroll
            for (int j = 0; j < 4; ++j) { const f32x4 scv = scp[64 * j], shv = shp[64 * j]; v[j] = v[j] * rstd * (scv + 1.0f) + shv;
                o8[64 * j] = (unsigned long long)pk2(v[j].x, v[j].y) | ((unsigned long long)pk2(v[j].z, v[j].w) << 32);
                if (U8) { int w8 = __builtin_amdgcn_cvt_pk_fp8_f32(v[j].x, v[j].y, 0, false); w8 = __builtin_amdgcn_cvt_pk_fp8_f32(v[j].z, v[j].w, w8, true); ((unsigned*)(U8 + (size_t)m * D))[F.lane + 64 * j] = (unsigned)w8; }
                if (wf_l >= 0) { const f32x4* wp = (const f32x4*)(wf + 4 * (4 * F.lane + 256 * j)); fa += wp[0] * v[j].x + wp[1] * v[j].y + wp[2] * v[j].z + wp[3] * v[j].w; } }
            if (wf_l >= 0) {
                fa.x = wave_sum(fa.x); fa.y = wave_sum(fa.y); fa.z = wave_sum(fa.z); fa.w = wave_sum(fa.w);
                if (F.lane < 4) { float z = (F.lane == 0) ? fa.x : (F.lane == 1) ? fa.y : (F.lane == 2) ? fa.z : fa.w; z += a.b_in[(size_t)wf_l * INW + FCOL + F.lane];
                    const float ls = fminf(z, 0.f) - 0.6931471805599453f * __builtin_amdgcn_logf(1.0f + __builtin_amdgcn_exp2f(-1.4426950408889634f * fabsf(z)));
                    ((float*)(a.ws + WS_LOGF))[(size_t)(b * 4 + F.lane) * SEQ + (m & (SEQ - 1))] = ls; }
            }
        }
            }
    }
    __syncthreads();
}
__device__ __forceinline__ void phase_prep(const Frame& F, const Args& a, int l) {
    bf16* P = (bf16*)(a.ws + WS_R1); bf16* Y = (bf16*)(a.ws + WS_Y); const float* rope = (const float*)(a.ws + WS_ROPE);
    const int tid = F.tid;
    { float* red = (float*)F.lds; float* red2 = red + 256 * 65;
      for (int item = blockIdx.x; item < 512; item += F.G) {
        const int tb = item >> 2, h = item & 3, i = tid & 255, which = tid >> 8; const size_t row = (size_t)tb * 256 + i;
        bf16* p = P + row * NA + 1024 + which * 256 + h * 64;
        const v4u c0 = *(const v4u*)p, c1 = *(const v4u*)(p + 8);
        float t1[8] = {bflo(c0.x), bfhi(c0.x), bflo(c0.y), bfhi(c0.y), bflo(c0.z), bfhi(c0.z), bflo(c0.w), bfhi(c0.w)};
        float t2[8] = {bflo(c1.x), bfhi(c1.x), bflo(c1.y), bfhi(c1.y), bflo(c1.z), bfhi(c1.z), bflo(c1.w), bfhi(c1.w)};
        const f32x4 cA = *(const f32x4*)(rope + row * 16), cB = *(const f32x4*)(rope + row * 16 + 4), sA = *(const f32x4*)(rope + row * 16 + 8), sB = *(const f32x4*)(rope + row * 16 + 12);
        const float cs[8] = {cA.x, cA.y, cA.z, cA.w, cB.x, cB.y, cB.z, cB.w}, sn[8] = {sA.x, sA.y, sA.z, sA.w, sB.x, sB.y, sB.z, sB.w};
        float r1[8], r2[8];
#pragma unroll
        for (int d = 0; d < 8; ++d) { r1[d] = t1[d] * cs[d] - t2[d] * sn[d]; r2[d] = t2[d] * cs[d] + t1[d] * sn[d]; }
        v4u o0, o1; o0.x = pk2(r1[0], r1[1]); o0.y = pk2(r1[2], r1[3]); o0.z = pk2(r1[4], r1[5]); o0.w = pk2(r1[6], r1[7]);
        o1.x = pk2(r2[0], r2[1]); o1.y = pk2(r2[2], r2[3]); o1.z = pk2(r2[4], r2[5]); o1.w = pk2(r2[6], r2[7]);
        *(v4u*)p = o0; *(v4u*)(p + 8) = o1;
        if (which == 1) {
            float* rr = red + i * 65;
#pragma unroll
            for (int d = 0; d < 8; ++d) { rr[d] = r1[d]; rr[8 + d] = r2[d]; }
#pragma unroll
            for (int ch = 2; ch < 8; ++ch) { const v4u cv = *(const v4u*)(p + 8 * ch);
                rr[8 * ch + 0] = bflo(cv.x); rr[8 * ch + 1] = bfhi(cv.x); rr[8 * ch + 2] = bflo(cv.y); rr[8 * ch + 3] = bfhi(cv.y);
                rr[8 * ch + 4] = bflo(cv.z); rr[8 * ch + 5] = bfhi(cv.z); rr[8 * ch + 6] = bflo(cv.w); rr[8 * ch + 7] = bfhi(cv.w); }
        }
        {
          const bf16* pf = P + row * NA + 1792 + which * 256 + h * 64; float ss = 0.f;
#pragma unroll
          for (int ch = 0; ch < 8; ++ch) { const v4u cv = *(const v4u*)(pf + 8 * ch);
              ss += bflo(cv.x) * bflo(cv.x) + bfhi(cv.x) * bfhi(cv.x) + bflo(cv.y) * bflo(cv.y) + bfhi(cv.y) * bfhi(cv.y) + bflo(cv.z) * bflo(cv.z) + bfhi(cv.z) * bfhi(cv.z) + bflo(cv.w) * bflo(cv.w) + bfhi(cv.w) * bfhi(cv.w); }
#pragma unroll
          for (int o = 1; o < 64; o <<= 1) ss = fmaxf(ss, __shfl_xor(ss, o));
          if (F.lane == 0) red2[512 + F.wave] = ss; }
        __syncthreads();
        { const int col = tid & 63, part = tid >> 6; float s = 0.f;
          for (int r = 0; r < 32; ++r) s += red[(part * 32 + r) * 65 + col];
          red2[part * 64 + col] = s; }
        __syncthreads();
        if (tid < 64) { float s = 0.f;
#pragma unroll
            for (int pp = 0; pp < 8; ++pp) s += red2[pp * 64 + tid];
            ((float*)(a.ws + WS_KBAR))[((size_t)((tb >> 5) * 4 + h) * 32 + (tb & 31)) * 64 + tid] = s * (1.0f / 256.0f);
            if (tid < 2) ((float*)(a.ws + WS_NRM))[((size_t)((tb >> 5) * 4 + h) * 32 + (tb & 31)) * 2 + tid] = fmaxf(fmaxf(red2[512 + 4 * tid], red2[512 + 4 * tid + 1]), fmaxf(red2[512 + 4 * tid + 2], red2[512 + 4 * tid + 3])) * 1.02f; }
        __syncthreads();
      } }
    { double* ds = (double*)F.lds;
      for (int seq = blockIdx.x; seq < 16; seq += F.G) {
        const float* lf = (const float*)(a.ws + WS_LOGF) + (size_t)seq * SEQ + 16 * tid; float* kb = (float*)(a.ws + WS_KBIAS) + (size_t)seq * SEQ + 16 * tid;
        f32x4 q[4];
#pragma unroll
        for (int j = 0; j < 4; ++j) q[j] = *(const f32x4*)(lf + 4 * j);
        double tot = 0.0;
#pragma unroll
        for (int j = 0; j < 4; ++j) tot += ((double)q[j].x + (double)q[j].y) + ((double)q[j].z + (double)q[j].w);
        double inc = tot;
#pragma unroll
        for (int o = 1; o < 64; o <<= 1) { const double up = __shfl_up(inc, o); if (F.lane >= o) inc += up; }
        if (F.lane == 63) ds[F.wave] = inc;
        __syncthreads();
        double run = inc - tot;
        for (int j = 0; j < F.wave; ++j) run += ds[j];
#pragma unroll
        for (int j = 0; j < 4; ++j) { f32x4 o; run += (double)q[j].x; o.x = (float)(run * -1.4426950408889634); run += (double)q[j].y; o.y = (float)(run * -1.4426950408889634);
            run += (double)q[j].z; o.z = (float)(run * -1.4426950408889634); run += (double)q[j].w; o.w = (float)(run * -1.4426950408889634); *(f32x4*)(kb + 4 * j) = o; }
        __syncthreads();
      } }
    { float* WP = (float*)F.lds; float* PL = WP + 4 * 64 * 64;
      const float* wpg = a.w_pool + (size_t)l * 4 * 64 * 64;
      for (int i = tid; i < 4 * 64 * 64 / 4; i += NWAVES * 64) *(f32x4*)(WP + 4 * i) = *(const f32x4*)(wpg + 4 * i);
      const int ch = tid & 255, half = tid >> 8, g = ch >> 6, w = 2 << g;
      const float pscale = a.pool_scale[l * 256 + ch];
      for (int item = blockIdx.x; item < T / 32; item += F.G) {
        const int row0 = item * 32 + half * 16, s0 = row0 & (SEQ - 1);
        float vals[31];
#pragma unroll
        for (int j = 0; j < 31; ++j) { const int sj = s0 - 15 + j; vals[j] = (sj >= 0) ? __uint_as_float(((unsigned)P[(size_t)(row0 - 15 + j) * NA + ch]) << 16) : 0.f; }
#pragma unroll
        for (int tt = 0; tt < 16; ++tt) { float sum = 0.f;
#pragma unroll
            for (int dd = 0; dd < 16; ++dd) if (dd < w) sum += vals[15 + tt - dd];
            const int cnt = min(s0 + tt + 1, w);
            PL[(half * 16 + tt) * 256 + ch] = sum * __builtin_amdgcn_rcpf((float)cnt) - vals[15 + tt]; }
        __syncthreads();
        { const int cq = tid & 63, tg = tid >> 6, g2 = cq >> 4, d0 = 4 * (cq & 15);
          f32x4 acc4[4];
#pragma unroll
          for (int t = 0; t < 4; ++t) acc4[t] = (f32x4){0.f, 0.f, 0.f, 0.f};
          const float* wb = WP + g2 * 4096 + d0; const float* pb = PL + (4 * tg) * 256 + g2 * 64;
          for (int c = 0; c < 64; c += 4) {
              const f32x4 w0 = *(const f32x4*)(wb + c * 64), w1 = *(const f32x4*)(wb + (c + 1) * 64), w2 = *(const f32x4*)(wb + (c + 2) * 64), w3 = *(const f32x4*)(wb + (c + 3) * 64);
#pragma unroll
              for (int t = 0; t < 4; ++t) { const f32x4 pv = *(const f32x4*)(pb + t * 256 + c); acc4[t] += w0 * pv.x + w1 * pv.y + w2 * pv.z + w3 * pv.w; } }
          const f32x4 ps = *(const f32x4*)(a.pool_scale + l * 256 + 4 * cq);
#pragma unroll
          for (int t = 0; t < 4; ++t) { const f32x4 o = acc4[t] * ps; v2u ov; ov.x = pk2(o.x, o.y); ov.y = pk2(o.z, o.w);
              *(v2u*)(Y + (size_t)(item * 32 + 4 * tg + t) * 256 + 4 * cq) = ov; } }
        __syncthreads();
      } }
    { bf16* Yc = Y + (size_t)T * 256; const float* cw = a.conv_w + (size_t)l * 3 * 256;
      const int gt = blockIdx.x * (NWAVES * 64) + tid, GT = F.G * NWAVES * 64; const int oc = (gt & 31) * 8;
      f32x4 cwv[3][2];
#pragma unroll
      for (int k = 0; k < 3; ++k) { cwv[k][0] = *(const f32x4*)(cw + k * 256 + oc); cwv[k][1] = *(const f32x4*)(cw + k * 256 + oc + 4); }
      for (int idx = gt; idx < (T / 4) * 32; idx += GT) { const int row0 = (idx >> 5) * 4, s0 = row0 & (SEQ - 1);
        const bf16* p = P + (size_t)row0 * NA + oc;
        v4u cc[6], hh[6], bb[4];
#pragma unroll
        for (int j = 0; j < 6; ++j) { if (s0 + j - 2 >= 0) { cc[j] = *(const v4u*)(p + (ptrdiff_t)(j - 2) * NA + 512); hh[j] = *(const v4u*)(p + (ptrdiff_t)(j - 2) * NA + 768); }
                                      else { cc[j] = (v4u){0u, 0u, 0u, 0u}; hh[j] = (v4u){0u, 0u, 0u, 0u}; } }
#pragma unroll
        for (int t = 0; t < 4; ++t) bb[t] = *(const v4u*)(p + (size_t)t * NA + 256);
        float v[6][8];
#pragma unroll
        for (int j = 0; j < 6; ++j) { v[j][0] = bflo(cc[j].x) * bflo(hh[j].x); v[j][1] = bfhi(cc[j].x) * bfhi(hh[j].x); v[j][2] = bflo(cc[j].y) * bflo(hh[j].y); v[j][3] = bfhi(cc[j].y) * bfhi(hh[j].y);
                                      v[j][4] = bflo(cc[j].z) * bflo(hh[j].z); v[j][5] = bfhi(cc[j].z) * bfhi(hh[j].z); v[j][6] = bflo(cc[j].w) * bflo(hh[j].w); v[j][7] = bfhi(cc[j].w) * bfhi(hh[j].w); }
#pragma unroll
        for (int t = 0; t < 4; ++t) { float z[8];
#pragma unroll
            for (int e = 0; e < 8; ++e) { const float w0 = e < 4 ? cwv[0][0][e] : cwv[0][1][e - 4], w1 = e < 4 ? cwv[1][0][e] : cwv[1][1][e - 4], w2 = e < 4 ? cwv[2][0][e] : cwv[2][1][e - 4];
                z[e] = w0 * v[t][e] + w1 * v[t + 1][e] + w2 * v[t + 2][e]; }
            const v4u b4 = bb[t];
            v4u o; o.x = pk2(z[0] * bflo(b4.x), z[1] * bfhi(b4.x)); o.y = pk2(z[2] * bflo(b4.y), z[3] * bfhi(b4.y)); o.z = pk2(z[4] * bflo(b4.z), z[5] * bfhi(b4.z)); o.w = pk2(z[6] * bflo(b4.w), z[7] * bfhi(b4.w));
            *(v4u*)(Yc + (size_t)(row0 + t) * 256 + oc) = o; } } }
    __syncthreads();
}
typedef short mbf16x8 __attribute__((ext_vector_type(8)));
typedef float mf32x16 __attribute__((ext_vector_type(16)));
__device__ __forceinline__ void phase_merge(const Frame& F, const bf16* Y, const bf16* WB, const unsigned char* G, bf16* Mout) {
    unsigned char* lb = F.lds;
    const int tid = F.tid, lane = F.lane, w = F.wave, i32 = lane & 31, hi = lane >> 5;
    for (int unit = F.vcu; unit < (T / 256) * (D / 128); unit += F.G) {
        const int pm = unit >> 3, pn = unit & 7, c0 = pn * 128; const size_t row = (size_t)pm * 256 + w * 32 + i32;
        mf32x16 sum[4];
#pragma unroll
        for (int cb = 0; cb < 4; ++cb)
#pragma unroll
            for (int r = 0; r < 16; ++r) sum[cb][r] = 0.f;
        for (int n = 0; n < 4; ++n) {
            const bf16* yp = Y + ((size_t)n * T + row) * 256 + 8 * hi;
            mbf16x8 yf[16];
#pragma unroll
            for (int ks = 0; ks < 16; ++ks) yf[ks] = *(const mbf16x8*)(yp + 16 * ks);
            __syncthreads();
            { const unsigned char* wp = (const unsigned char*)(WB + ((size_t)n * D + c0) * 256);
              v4u tmp[8];
#pragma unroll
              for (int i = 0; i < 8; ++i) tmp[i] = *(const v4u*)(wp + (size_t)(tid + 512 * i) * 16);
#pragma unroll
              for (int i = 0; i < 8; ++i) { const int q = tid + 512 * i; *(v4u*)(lb + (q >> 5) * 528 + (q & 31) * 16) = tmp[i]; } }
            __syncthreads();
            mf32x16 acc[4];
#pragma unroll
            for (int cb = 0; cb < 4; ++cb)
#pragma unroll
                for (int r = 0; r < 16; ++r) acc[cb][r] = 0.f;
            const unsigned char* lrow = lb + i32 * 528 + 16 * hi;
#pragma unroll
            for (int ks = 0; ks < 16; ++ks)
#pragma unroll
                for (int cb = 0; cb < 4; ++cb) { const mbf16x8 wf = *(const mbf16x8*)(lrow + cb * 32 * 528 + 32 * ks);
                    acc[cb] = __builtin_amdgcn_mfma_f32_32x32x16_bf16(wf, yf[ks], acc[cb], 0, 0, 0); }
            const unsigned char* gp = G + ((size_t)n * T + row) * D + c0 + 4 * hi;
#pragma unroll
            for (int cb = 0; cb < 4; ++cb)
#pragma unroll
                for (int g = 0; g < 4; ++g) { const unsigned gw = *(const unsigned*)(gp + 32 * cb + 8 * g);
                    sum[cb][4 * g + 0] += acc[cb][4 * g + 0] * (float)(gw & 255u); sum[cb][4 * g + 1] += acc[cb][4 * g + 1] * (float)((gw >> 8) & 255u);
                    sum[cb][4 * g + 2] += acc[cb][4 * g + 2] * (float)((gw >> 16) & 255u); sum[cb][4 * g + 3] += acc[cb][4 * g + 3] * (float)(gw >> 24); }
        }
        bf16* mp = Mout + row * D + c0 + 4 * hi;
#pragma unroll
        for (int cb = 0; cb < 4; ++cb)
#pragma unroll
            for (int g = 0; g < 4; ++g) { const float q = 1.0f / 255.0f; v2u o; o.x = pk2(sum[cb][4 * g + 0] * q, sum[cb][4 * g + 1] * q); o.y = pk2(sum[cb][4 * g + 2] * q, sum[cb][4 * g + 3] * q); *(v2u*)(mp + 32 * cb + 8 * g) = o; }
    }
    __syncthreads();
}
#ifdef PROBE
__device__ __forceinline__ void probe_dump(float* out, const bf16* src, int pitch, const float* small, int nsmall) {
    const size_t gt = (size_t)blockIdx.x * 512 + threadIdx.x, GT = (size_t)gridDim.x * 512;
    for (size_t i = gt; i < (size_t)T * D; i += GT) { const size_t row = i >> 10; const int c = (int)(i & 1023); float s = 0.f;
        for (int j = c; j < pitch; j += 1024) s += __uint_as_float(((unsigned)src[row * pitch + j]) << 16);
        if (small) s += small[i % nsmall];
        out[i] = s; }
}
#endif
#define LAS __attribute__((address_space(3)))
#define XB_TMO      128
#define XB_XCNT(j)  (256  + 64 * (j))
#define XB_XSUB(j)  (1280 + 64 * (j))
#define XB_XGEN(j)  (2304 + 64 * (j))
#define XB_TOP      3328
#define XB_TOPGEN   3392
#define XCD_BAR_WORDS 3456
#define XB_SPIN_CAP (1u << 18)

__device__ __forceinline__ unsigned xb_ld(unsigned* p)              { return __hip_atomic_load(p, __ATOMIC_RELAXED, __HIP_MEMORY_SCOPE_AGENT); }
__device__ __forceinline__ unsigned xb_add(unsigned* p, unsigned v) { return __hip_atomic_fetch_add(p, v, __ATOMIC_RELAXED, __HIP_MEMORY_SCOPE_AGENT); }
__device__ __forceinline__ unsigned xb_xcc_id() { return (unsigned)__builtin_amdgcn_s_getreg((3 << 11) | 20) & 0xFu; }
#define XB_SPIN(cond, bar) do { unsigned _sp = 0; while (cond) { __builtin_amdgcn_s_sleep(1); \
    if ((++_sp & 255u) == 0u) { if (xb_ld(&(bar)[XB_TMO])) break; if (_sp > XB_SPIN_CAP) { atomicAdd(&(bar)[XB_TMO], 1u); break; } } } } while (0)

struct XcdBarrier {
    unsigned* bar; unsigned x;
    volatile LAS unsigned* st;
};

__device__ __forceinline__ XcdBarrier xcd_barrier_post(unsigned* bar, volatile LAS unsigned* st) {
    XcdBarrier b; b.bar = bar; b.x = xb_xcc_id(); b.st = st;
    if (threadIdx.x == 0) (void)xb_add(&bar[XB_XCNT(b.x)], 1u);
    return b;
}
__device__ __forceinline__ void xcd_barrier_complete(unsigned* bar, unsigned x, unsigned& nloc, unsigned& nx) {
    const unsigned G = gridDim.x * gridDim.y * gridDim.z;
    unsigned sum, cnt, mine, sp = 0u;
    for (;;) {
        sum = 0u; cnt = 0u; mine = 0u;
#pragma unroll
        for (unsigned j = 0; j < 16; ++j) { const unsigned c = xb_ld(&bar[XB_XCNT(j)]); sum += c; cnt += (c > 0u) ? 1u : 0u; mine = (j == x) ? c : mine; }
        if (sum == G) break;
        __builtin_amdgcn_s_sleep(1);
        if ((++sp & 255u) == 0u) { if (xb_ld(&bar[XB_TMO])) break; if (sp > XB_SPIN_CAP) { atomicAdd(&bar[XB_TMO], 1u); break; } }
    }
    nloc = mine > 0u ? mine : 1u; nx = cnt > 0u ? cnt : 1u;
}

__device__ __forceinline__ void xcd_barrier(const XcdBarrier& b) {
    asm volatile("s_waitcnt vmcnt(0)" ::: "memory");
    __syncthreads();
    if (threadIdx.x == 0) {
        unsigned* bar = b.bar;
        __builtin_amdgcn_s_waitcnt(0);
        unsigned nloc = b.st[0], nx = b.st[1];
        if (nloc == 0u) { xcd_barrier_complete(bar, b.x, nloc, nx); b.st[0] = nloc; b.st[1] = nx; }
        const unsigned old = xb_add(&bar[XB_XSUB(b.x)], 1u);
        const unsigned gen = old / nloc;
        if (old + 1u == (gen + 1u) * nloc) {
            __builtin_amdgcn_fence(__ATOMIC_RELEASE, "agent");
            asm volatile("s_waitcnt vmcnt(0)" ::: "memory");
            const unsigned og = xb_add(&bar[XB_TOP], 1u);
            const unsigned tg = og / nx;
            if (og + 1u == (tg + 1u) * nx) xb_add(&bar[XB_TOPGEN], 1u);
            else XB_SPIN(xb_ld(&bar[XB_TOPGEN]) == tg, bar);
            __builtin_amdgcn_fence(__ATOMIC_ACQUIRE, "agent");
            xb_add(&bar[XB_XGEN(b.x)], 1u);
            asm volatile("s_waitcnt vmcnt(0)" ::: "memory");
        } else {
            XB_SPIN(xb_ld(&bar[XB_XGEN(b.x)]) == gen, bar);
            __builtin_amdgcn_fence(__ATOMIC_ACQUIRE, "agent");
            asm volatile("s_waitcnt vmcnt(0)" ::: "memory");
        }
    }
    __syncthreads();
}
constexpr int ARGV_OFF = RING_BYTES + 1024;
#define ARG_LIST(X) X(0, x) X(1, c) X(2, pos) X(3, w_ada) X(4, b_ada) X(5, w_in) X(6, b_in) X(7, w_pool) X(8, pool_scale) X(9, conv_w) X(10, w_branch) X(11, w_o) X(12, ln1_g) X(13, ln1_b) X(14, w_up) X(15, b_up) X(16, w_down) X(17, ln2_g) X(18, ln2_b) X(19, out) X(20, ws)
typedef __attribute__((address_space(3))) volatile unsigned lds_vu32;
template <class Tp> __device__ __forceinline__ Tp* ldarg(lds_vu32* argv, int i) {
    const unsigned lo = __builtin_amdgcn_readfirstlane(argv[2 * i]), hi = __builtin_amdgcn_readfirstlane(argv[2 * i + 1]);
    typedef __attribute__((address_space(1))) Tp* gptr_t;
    return (Tp*)(gptr_t)(((unsigned long long)hi << 32) | lo);
}
__device__ __forceinline__ Args load_args(lds_vu32* argv) {
    Args a;
#define X(i, name) a.name = ldarg<typename std::remove_pointer<decltype(a.name)>::type>(argv, i);
    ARG_LIST(X)
#undef X
    return a;
}
__global__ void __launch_bounds__(NWAVES * 64, 2) fwd_megakernel(Args a0) {
    extern __shared__ __attribute__((aligned(16))) unsigned char lds[];
    cg::grid_group grid = cg::this_grid();
    lds_vu32* argv = (lds_vu32*)(unsigned)ARGV_OFF;
    if (threadIdx.x == 0) {
#define X(i, name) { const unsigned long long v_ = (unsigned long long)a0.name; argv[2 * i] = (unsigned)v_; argv[2 * i + 1] = (unsigned)(v_ >> 32); }
        ARG_LIST(X)
#undef X
    }
    if (threadIdx.x == 0) { volatile LAS unsigned* st_ = (volatile LAS unsigned*)(unsigned)(ARGV_OFF + 512); st_[0] = 0u; st_[1] = 0u; }
    __syncthreads();
    (void)xcd_barrier_post((unsigned*)(a0.ws + WS_BAR), (volatile LAS unsigned*)(unsigned)(ARGV_OFF + 512));
    Frame F; F.lds = lds;
    PG8_LAS unsigned char* lds3 = (PG8_LAS unsigned char*)lds;
#define GSYNC_CG() do { asm volatile("s_waitcnt vmcnt(0) lgkmcnt(0)" ::: "memory"); __syncthreads(); if (threadIdx.x == 0) { asm volatile("buffer_wbl2 sc1\n\ts_waitcnt vmcnt(0)" ::: "memory"); } grid.sync(); asm volatile("buffer_inv sc1\n\ts_waitcnt vmcnt(0)" ::: "memory"); } while (0)
#define GSYNC() do { XcdBarrier b_; b_.bar = (unsigned*)(ldarg<unsigned char>(argv, 20) + WS_BAR); b_.x = xb_xcc_id(); b_.st = (volatile LAS unsigned*)(unsigned)(ARGV_OFF + 512); xcd_barrier(b_); } while (0)
#define PHASE_BEGIN() int t_ = threadIdx.x; asm volatile("" : "+v"(t_)); F.tid = t_; F.lane = t_ & 63; F.wave = __builtin_amdgcn_readfirstlane(t_ >> 6); \
    int G_ = gridDim.x, bx_ = blockIdx.x; asm volatile("" : "+s"(G_), "+s"(bx_)); F.G = G_; F.vcu = (G_ % 8 == 0) ? (bx_ % 8) * (G_ / 8) + bx_ / 8 : bx_; \
    unsigned ab_ = ARGV_OFF; asm volatile("" : "+v"(ab_)); const Args a = load_args((lds_vu32*)ab_); unsigned char* ws = a.ws; float* ADA = (float*)(ws + WS_ADA); bf16* U = (bf16*)(ws + WS_U); bf16* Y = (bf16*)(ws + WS_Y); bf16* R1 = (bf16*)(ws + WS_R1); \
    (void)ADA; (void)U; (void)Y; (void)R1
#ifndef ONLY
#define ON(k) 1
#else
#define ON(k) ((ONLY>>(k))&1)
#endif
    if (ON(0)) { PHASE_BEGIN(); phase_ada(F, a); }
    GSYNC_CG();
    if (ON(1)) { PHASE_BEGIN(); phase_ln(F, a, a.x, nullptr, nullptr, nullptr, ADA + 0 * D, ADA + 1 * D, U, 0); }
    GSYNC();
#if defined(PROBE) && PROBE == 12
    { PHASE_BEGIN(); const bf16* wsrc = (const bf16*)(ws + WS_WINA); const size_t gt = (size_t)blockIdx.x * 512 + threadIdx.x, GT = (size_t)gridDim.x * 512;
      for (size_t i = gt; i < (size_t)T * D; i += GT) a.out[i] = __uint_as_float(((unsigned)wsrc[i % (size_t)(33 * 512 * 1024)]) << 16); return; }
#endif
#if defined(PROBE) && PROBE == 1
    { PHASE_BEGIN(); probe_dump(a.out, U, 1024, (const float*)(ws + WS_ADA), 4 * 4 * 6144); return; }
#endif
    for (int l = 0; l < DEPTH; ++l) {
        if (ON(2)) { PHASE_BEGIN(); pg8::Gemm g{U, (bf16*)(ws + WS_WINA), T, NA, D}; pg8::StaticOrder S; S.init(T, NA, F.G, bx_);
          pg8::EpiAct<0> E{R1, NA, a.b_in + (size_t)l * INW, 0, 0, 4, 7, attn_body::C2};
          pg8::gemm_phase<pg8::EpiAct<0>, pg8::StaticOrder, true, true>(lds3, g, S, E); }
        GSYNC();
#if defined(PROBE) && PROBE == 2
        { PHASE_BEGIN(); probe_dump(a.out, R1, NA, (const float*)(ws + WS_LOGF), 16 * SEQ); return; }
#endif
        if (ON(3)) { PHASE_BEGIN(); phase_prep(F, a, l); }
        GSYNC();
#if defined(PROBE) && PROBE == 3
        { PHASE_BEGIN(); probe_dump(a.out, R1, NA, (const float*)(ws + WS_KBIAS), 16 * SEQ + 32768 * 0); return; }
#endif
#if defined(PROBE) && PROBE == 31
        { PHASE_BEGIN(); probe_dump(a.out, Y, 512, (const float*)(ws + WS_KBAR), 32768); return; }
#endif
        if (ON(4)) { PHASE_BEGIN(); const attn_body::AttnTensors AT{(const attn_body::bf16*)R1, (attn_body::bf16*)Y, (const float*)(ws + WS_KBIAS), (const float*)(ws + WS_KBAR), (const float*)(ws + WS_NRM)};
          attn_body::attn_phase<40>((char*)lds, AT, F.vcu, F.G); }
        GSYNC();
#if defined(PROBE) && PROBE == 4
        { PHASE_BEGIN(); probe_dump(a.out, Y + (size_t)2 * T * 256, 512, nullptr, 1); return; }
#endif
        if (ON(5)) { PHASE_BEGIN(); pg8::Gemm g{U, (bf16*)(ws + WS_WG), T, NG, D}; pg8::StaticOrder S; S.init(T, NG, F.G, bx_);
          pg8::EpiGate8 E{ws + WS_R1, a.b_in + (size_t)l * INW + GCOL, 1.0f};
          pg8::gemm_phase<pg8::EpiGate8, pg8::StaticOrder, true, true>(lds3, g, S, E); }
        GSYNC();
#if defined(PROBE) && PROBE == 5
        { PHASE_BEGIN(); probe_dump(a.out, R1, 4096, nullptr, 1); return; }
#endif
        if (ON(6)) { PHASE_BEGIN(); phase_merge(F, Y, (const bf16*)(ws + WS_WB), ws + WS_R1, U); }
        GSYNC();
#if defined(PROBE) && PROBE == 6
        { PHASE_BEGIN(); probe_dump(a.out, R1, 1024, nullptr, 1); return; }
#endif
        if (ON(7)) { PHASE_BEGIN(); pg8::Gemm g{U, (bf16*)(ws + WS_WO), T, D, D}; pg8::StaticOrder S; S.init(T, D, F.G, bx_);
          if (l == 0) { pg8::EpiRes<true> E{a.x, (bf16*)(ws + WS_YB), ADA + 2 * D, nullptr}; pg8::gemm_phase<pg8::EpiRes<true>, pg8::StaticOrder, true, true>(lds3, g, S, E); }
          else { pg8::EpiRes<false> E{ws + WS_YB, (bf16*)(ws + WS_YB), ADA + (size_t)l * BATCH * 6 * D + 2 * D, (const float*)(ws + WS_STATS)}; pg8::gemm_phase<pg8::EpiRes<false>, pg8::StaticOrder, true, true>(lds3, g, S, E); } }
        GSYNC();
#if defined(PROBE) && PROBE == 7
        return;
#endif
        if (ON(8)) { PHASE_BEGIN(); const float* ada_l = ADA + (size_t)l * BATCH * 6 * D; phase_ln(F, a, nullptr, nullptr, a.ln1_g + l * D, a.ln1_b + l * D, ada_l + 3 * D, ada_l + 4 * D, U, -1, (float*)(ws + WS_STATS), (const bf16*)(ws + WS_YB)); }
        GSYNC();
#if defined(PROBE) && PROBE == 8
        return;
#endif
        if (ON(9)) { PHASE_BEGIN(); pg8::Gemm g{U, (bf16*)(ws + WS_WUP), T, FF, D}; pg8::StaticOrder S; S.init(T, FF, F.G, bx_);
          pg8::EpiAct<2> E{R1, FF, a.b_up + (size_t)l * FF, 0, 0, -1, -1, 1.f};
          pg8::gemm_phase<pg8::EpiAct<2>, pg8::StaticOrder, true, true>(lds3, g, S, E); }
        GSYNC();
#if defined(PROBE) && PROBE == 9
        { PHASE_BEGIN(); probe_dump(a.out, R1, 4096, nullptr, 1); return; }
#endif
        if (ON(10)) { PHASE_BEGIN(); pg8::Gemm g{R1, (bf16*)(ws + WS_WDN), T, D, FF}; pg8::StaticOrder S; S.init(T, D, F.G, bx_);
          pg8::EpiRes<false> E{ws + WS_YB, (bf16*)(ws + WS_YB), ADA + (size_t)l * BATCH * 6 * D + 5 * D, (const float*)(ws + WS_STATS)};
          pg8::gemm_phase<pg8::EpiRes<false>, pg8::StaticOrder, true, true>(lds3, g, S, E); }
        GSYNC();
#if defined(PROBE) && PROBE == 10
        return;
#endif
        if (ON(11)) { PHASE_BEGIN();
            if (l + 1 < DEPTH) { const float* ada_n = ADA + (size_t)(l + 1) * BATCH * 6 * D;
                phase_ln(F, a, nullptr, nullptr, a.ln2_g + l * D, a.ln2_b + l * D, ada_n + 0 * D, ada_n + 1 * D, U, l + 1, (float*)(ws + WS_STATS), (const bf16*)(ws + WS_YB));
                convert_weights(F, a, l + 1); }
            else phase_ln(F, a, nullptr, a.out, a.ln2_g + l * D, a.ln2_b + l * D, nullptr, nullptr, nullptr, -1, nullptr, (const bf16*)(ws + WS_YB)); }
        if (l + 1 < DEPTH) GSYNC();
    }
}
extern "C" void kernel_launch(void* const* d_in, const int* in_sizes, int n_in, void* d_out, int out_size, void* d_ws, size_t ws_size, hipStream_t stream) {
    static int grid = 0;
    if (grid == 0) {
        if (n_in != 19 || out_size != T * D || ws_size < WS_END) { fprintf(stderr, "kernel_launch: unexpected shapes: n_in %d out %d ws %zu\n", n_in, out_size, ws_size); grid = -1; return; }
        int dev = 0, cus = 0, per_cu = 0;
        (void)hipGetDevice(&dev); (void)hipDeviceGetAttribute(&cus, hipDeviceAttributeMultiprocessorCount, dev);
        (void)hipFuncSetAttribute((const void*)fwd_megakernel, hipFuncAttributeMaxDynamicSharedMemorySize, LDS_BYTES);
        (void)hipOccupancyMaxActiveBlocksPerMultiprocessor(&per_cu, (const void*)fwd_megakernel, NWAVES * 64, LDS_BYTES);
        if (per_cu < 1) per_cu = 1;
        grid = cus * per_cu; if (grid > 256) grid = 256;
        fprintf(stderr, "kernel_launch: grid %d (cus %d, per_cu %d), ws %zu\n", grid, cus, per_cu, ws_size);
    }
    if (grid < 0) return;
    Args a{};
    a.x = (const float*)d_in[0]; a.c = (const float*)d_in[1]; a.pos = (const int*)d_in[2]; a.w_ada = (const float*)d_in[3]; a.b_ada = (const float*)d_in[4];
    a.w_in = (const float*)d_in[5]; a.b_in = (const float*)d_in[6]; a.w_pool = (const float*)d_in[7]; a.pool_scale = (const float*)d_in[8]; a.conv_w = (const float*)d_in[9];
    a.w_branch = (const float*)d_in[10]; a.w_o = (const float*)d_in[11]; a.ln1_g = (const float*)d_in[12]; a.ln1_b = (const float*)d_in[13]; a.w_up = (const float*)d_in[14];
    a.b_up = (const float*)d_in[15]; a.w_down = (const float*)d_in[16]; a.ln2_g = (const float*)d_in[17]; a.ln2_b = (const float*)d_in[18];
    a.out = (float*)d_out; a.ws = (unsigned char*)d_ws;
    (void)hipMemsetAsync((unsigned char*)d_ws + WS_BAR, 0, BAR_ZERO_BYTES, stream);
    void* args[] = {&a};
    const hipError_t e = hipLaunchCooperativeKernel((void*)fwd_megakernel, dim3(grid), dim3(NWAVES * 64), args, LDS_BYTES, stream);
    if (e != hipSuccess) fprintf(stderr, "kernel_launch: cooperative launch failed: %s (grid %d)\n", hipGetErrorString(e), grid);
}
```

```cpp
#include <hip/hip_runtime.h>
#include <hip/hip_cooperative_groups.h>
#include <hip/hip_bf16.h>
#include <cstdio>
#include <cstdint>
#include <cmath>
#include <type_traits>
namespace cg = cooperative_groups;
namespace pg8 {
#define PG8_LAS __attribute__((address_space(3)))
typedef unsigned short bf16_t;
typedef short bf16x8 __attribute__((ext_vector_type(8)));
typedef float f32x4 __attribute__((ext_vector_type(4)));
typedef unsigned u32x4 __attribute__((ext_vector_type(4)));
constexpr int BM = 256, BK = 64, HALF = 128, HTB = HALF * BK * 2  , STAGE_BYTES = 8 * HTB, NXCD = 8, WGM = 8;

__host__ __device__ __forceinline__ int lds_byte(int r, int c) { const int st = (r >> 4) * 2 + (c >> 5), rr = r & 15, cc = c & 31, ob = rr * 64 + cc * 2; return st * 1024 + (ob ^ (((ob >> 9) & 1) << 5)); }
__host__ __device__ __forceinline__ void stage_rc(int b, int& R, int& C) { const int st = b / 1024, sb = b % 1024, swz = sb ^ (((sb >> 9) & 1) << 5); R = (st >> 1) * 16 + swz / 64; C = (st & 1) * 32 + (swz % 64) / 2; }
__host__ __device__ __forceinline__ int perm32(int rho) { const int n = rho >> 4, i = rho & 15; return 8 * (i >> 2) + 4 * n + (i & 3); }

struct Unit { int pm, pn; };
struct Gemm { const bf16_t* A; const bf16_t* Bt; int M, N, K; };

struct StaticOrder {
    int nM, nN, nwg, G, c;
    __host__ __device__ void init(int M, int N, int G_, int c_) { nM = M / BM; nN = N / BM; nwg = nM * nN; G = G_; c = c_; }
    __host__ __device__ bool next(int i, Unit& u) const {
        const long L = (long)i * G + c; if (L >= nwg) return false;
        int wgid = (int)L; { const int q = nwg / NXCD, r = nwg % NXCD, xcd = wgid % NXCD, off = wgid / NXCD; wgid = (xcd < r ? xcd * (q + 1) : r * (q + 1) + (xcd - r) * q) + off; }
        const int nig = WGM * nN, gid = wgid / nig, fm = gid * WGM, gsz = (nM - fm) < WGM ? (nM - fm) : WGM;
        u.pm = fm + ((wgid % nig) % gsz); u.pn = (wgid % nig) / gsz; return true;
    }
    __device__ __forceinline__ void a_ready(const Unit&) const {}
    __device__ __forceinline__ void done(const Unit&) const {}
};

typedef float f32x2c_t __attribute__((ext_vector_type(2))); typedef __bf16 bf16x2c_t __attribute__((ext_vector_type(2)));
__device__ __forceinline__ unsigned cvt_pk_bf16(float lo, float hi) { f32x2c_t v = {lo, hi}; bf16x2c_t b = __builtin_convertvector(v, bf16x2c_t); return __builtin_bit_cast(unsigned, b); }
typedef float f32x2 __attribute__((ext_vector_type(2)));
__device__ __forceinline__ float bf_lo(unsigned w) { return __uint_as_float(w << 16); }
__device__ __forceinline__ float bf_hi(unsigned w) { return __uint_as_float(w & 0xffff0000u); }
template <int ACT> struct EpiAct {
    static constexpr bool PERM = true, AFTER_DRAIN = false;
    bf16_t* O; int ldc; const float* bias; int split_cols; size_t split_stride; int qs0, qs1; float qscale;
    __device__ __forceinline__ float act(float v) const {
        if (ACT == 1) return __builtin_amdgcn_rcpf(1.0f + __builtin_amdgcn_exp2f(-1.4426950408889634f * v));
        if (ACT == 2) { const float r = v > 0.f ? v : 0.f; return r * r; }
        return v;
    }
    __device__ __forceinline__ void operator()(const f32x4 (&acc)[2][2][4][2], const Unit& u, int wr, int wc, int fr, int fq) const {
        const int row0 = u.pm * BM + wr * 64 + fr; int colt = u.pn * BM; bf16_t* base = O;
        if (split_cols) { const int t = colt / split_cols; base += (size_t)t * split_stride; colt -= t * split_cols; }
        const float sc = (u.pn == qs0 || u.pn == qs1) ? qscale : 1.f;
        const int col0 = colt + wc * 32 + 8 * fq, bcol0 = u.pn * BM + wc * 32 + 8 * fq;
        f32x4 bv[2][2];
#pragma unroll
        for (int bj = 0; bj < 2; ++bj)
#pragma unroll
            for (int n = 0; n < 2; ++n) bv[bj][n] = bias ? *(const f32x4*)(bias + bcol0 + bj * HALF + 4 * n) : (f32x4){0.f, 0.f, 0.f, 0.f};
#pragma unroll
        for (int ai = 0; ai < 2; ++ai)
#pragma unroll
            for (int m = 0; m < 4; ++m) { bf16_t* rowp = base + (size_t)(row0 + ai * HALF + m * 16) * ldc + col0;
#pragma unroll
                for (int bj = 0; bj < 2; ++bj) { f32x4 v0 = acc[ai][bj][m][0] + bv[bj][0], v1 = acc[ai][bj][m][1] + bv[bj][1];
                    if (ACT != 0) { v0 = (f32x4){act(v0[0]), act(v0[1]), act(v0[2]), act(v0[3])}; v1 = (f32x4){act(v1[0]), act(v1[1]), act(v1[2]), act(v1[3])}; }
                    v0 = v0 * sc; v1 = v1 * sc; u32x4 w; w.x = cvt_pk_bf16(v0[0], v0[1]); w.y = cvt_pk_bf16(v0[2], v0[3]); w.z = cvt_pk_bf16(v1[0], v1[1]); w.w = cvt_pk_bf16(v1[2], v1[3]);
                    *(u32x4*)(rowp + bj * HALF) = w; } }
    }
};
struct EpiGate8 {
    static constexpr bool PERM = true, AFTER_DRAIN = false;
    unsigned char* O; const float* bias; float pre;
    __device__ __forceinline__ unsigned q8(float v) const { const float s = __builtin_amdgcn_rcpf(1.0f + __builtin_amdgcn_exp2f(-1.4426950408889634f * v)); return (unsigned)(s * 255.0f + 0.5f); }
    __device__ __forceinline__ void operator()(const f32x4 (&acc)[2][2][4][2], const Unit& u, int wr, int wc, int fr, int fq) const {
        const int row0 = u.pm * BM + wr * 64 + fr; const int colt = u.pn * BM; const int t = colt >> 10;
        unsigned char* base = O + (size_t)t * ((size_t)32768 * 1024);
        const int col0 = (colt & 1023) + wc * 32 + 8 * fq, bcol0 = colt + wc * 32 + 8 * fq;
        f32x4 bv[2][2];
#pragma unroll
        for (int bj = 0; bj < 2; ++bj)
#pragma unroll
            for (int n = 0; n < 2; ++n) bv[bj][n] = *(const f32x4*)(bias + bcol0 + bj * HALF + 4 * n);
#pragma unroll
        for (int ai = 0; ai < 2; ++ai)
#pragma unroll
            for (int m = 0; m < 4; ++m) { unsigned char* rowp = base + (size_t)(row0 + ai * HALF + m * 16) * 1024 + col0;
#pragma unroll
                for (int bj = 0; bj < 2; ++bj) { const f32x4 v0 = acc[ai][bj][m][0] * pre + bv[bj][0], v1 = acc[ai][bj][m][1] * pre + bv[bj][1];
                    typedef unsigned u32x2 __attribute__((ext_vector_type(2))); u32x2 w;
                    w.x = q8(v0[0]) | (q8(v0[1]) << 8) | (q8(v0[2]) << 16) | (q8(v0[3]) << 24); w.y = q8(v1[0]) | (q8(v1[1]) << 8) | (q8(v1[2]) << 16) | (q8(v1[3]) << 24);
                    *(u32x2*)(rowp + bj * HALF) = w; }
                asm volatile("" ::: "memory"); }
    }
};
template <bool XF32> struct EpiRes {
    static constexpr bool PERM = true, AFTER_DRAIN = false;
    static constexpr int gate_bstride = 6 * 1024, NROWS = 32768; static constexpr float alpha = 1.681792830507429f;
    const void* xin; bf16_t* yout; const float* gate; const float* stats;
    __device__ __forceinline__ void operator()(const f32x4 (&acc)[2][2][4][2], const Unit& u, int wr, int wc, int fr, int fq) const {
        const int row0 = u.pm * BM + wr * 64 + fr, col0 = u.pn * BM + wc * 32 + 8 * fq; const int b = (u.pm * BM) >> 13;
        const float* gp = gate + (size_t)b * gate_bstride + col0;
        f32x4 gv[2][2], lg[2][2], lb[2][2];
#pragma unroll
        for (int bj = 0; bj < 2; ++bj)
#pragma unroll
            for (int n = 0; n < 2; ++n) { gv[bj][n] = *(const f32x4*)(gp + bj * HALF + 4 * n);
                if (!XF32) { lg[bj][n] = *(const f32x4*)(stats + 2 * NROWS + col0 + bj * HALF + 4 * n); lb[bj][n] = *(const f32x4*)(stats + 2 * NROWS + 1024 + col0 + bj * HALF + 4 * n); } }
#pragma unroll
        for (int ai = 0; ai < 2; ++ai)
#pragma unroll
            for (int mh = 0; mh < 2; ++mh) {
                f32x4 xv[2][2][2]; f32x2 st[2];
#pragma unroll
                for (int mm = 0; mm < 2; ++mm) { const int r = row0 + ai * HALF + (2 * mh + mm) * 16; const size_t off = (size_t)r * 1024 + col0;
                    if (XF32) { st[mm] = (f32x2){0.f, 0.f};
#pragma unroll
                        for (int bj = 0; bj < 2; ++bj)
#pragma unroll
                            for (int n = 0; n < 2; ++n) xv[mm][bj][n] = *(const f32x4*)((const float*)xin + off + bj * HALF + 4 * n);
                    } else { st[mm] = *(const f32x2*)(stats + 2 * (size_t)r);
#pragma unroll
                        for (int bj = 0; bj < 2; ++bj) { const u32x4 yw = *(const u32x4*)((const bf16_t*)xin + off + bj * HALF);
                            xv[mm][bj][0] = (f32x4){bf_lo(yw.x), bf_hi(yw.x), bf_lo(yw.y), bf_hi(yw.y)}; xv[mm][bj][1] = (f32x4){bf_lo(yw.z), bf_hi(yw.z), bf_lo(yw.w), bf_hi(yw.w)}; } } }
                asm volatile("" ::: "memory");
#pragma unroll
                for (int mm = 0; mm < 2; ++mm) { const int m = 2 * mh + mm; const size_t off = (size_t)(row0 + ai * HALF + m * 16) * 1024 + col0;
#pragma unroll
                    for (int bj = 0; bj < 2; ++bj) { f32x4 o[2];
#pragma unroll
                        for (int n = 0; n < 2; ++n) { f32x4 xa;
                            if (!XF32) xa = (xv[mm][bj][n] - st[mm].x) * st[mm].y * lg[bj][n] + lb[bj][n];
                            else xa = xv[mm][bj][n] * alpha;
                            o[n] = xa + gv[bj][n] * acc[ai][bj][m][n]; }
                        u32x4 w; w.x = cvt_pk_bf16(o[0][0], o[0][1]); w.y = cvt_pk_bf16(o[0][2], o[0][3]); w.z = cvt_pk_bf16(o[1][0], o[1][1]); w.w = cvt_pk_bf16(o[1][2], o[1][3]);
                        *(u32x4*)(yout + off + bj * HALF) = w; } }
                asm volatile("" ::: "memory"); }
    }
};
struct EpiMerge {
    static constexpr bool PERM = true, AFTER_DRAIN = false;
    const bf16_t* G; float* macc; bf16_t* Mout; int mode;
    __device__ __forceinline__ void operator()(const f32x4 (&acc)[2][2][4][2], const Unit& u, int wr, int wc, int fr, int fq) const {
        const int row0 = u.pm * BM + wr * 64 + fr, col0 = u.pn * BM + wc * 32 + 8 * fq;
#pragma unroll
        for (int ai = 0; ai < 2; ++ai)
#pragma unroll
            for (int m = 0; m < 4; ++m) { const size_t off = (size_t)(row0 + ai * HALF + m * 16) * 1024 + col0;
#pragma unroll
                for (int bj = 0; bj < 2; ++bj) { const u32x4 gw = *(const u32x4*)(G + off + bj * HALF);
                    f32x4 v0 = acc[ai][bj][m][0] * (f32x4){bf_lo(gw.x), bf_hi(gw.x), bf_lo(gw.y), bf_hi(gw.y)};
                    f32x4 v1 = acc[ai][bj][m][1] * (f32x4){bf_lo(gw.z), bf_hi(gw.z), bf_lo(gw.w), bf_hi(gw.w)};
                    if (mode != 0) { v0 += *(const f32x4*)(macc + off + bj * HALF); v1 += *(const f32x4*)(macc + off + bj * HALF + 4); }
                    if (mode != 2) { *(f32x4*)(macc + off + bj * HALF) = v0; *(f32x4*)(macc + off + bj * HALF + 4) = v1; }
                    else { u32x4 w; w.x = cvt_pk_bf16(v0[0], v0[1]); w.y = cvt_pk_bf16(v0[2], v0[3]); w.z = cvt_pk_bf16(v1[0], v1[1]); w.w = cvt_pk_bf16(v1[2], v1[3]); *(u32x4*)(Mout + off + bj * HALF) = w; } }
                asm volatile("" ::: "memory"); }
    }
};

template <class Epi, class Sched, bool ALIGN_EPI = false, bool SP2 = false>
__device__ __forceinline__ void gemm_phase(PG8_LAS unsigned char* lds, const Gemm g, const Sched& S, const Epi& E) {
    int tid_ = threadIdx.x; asm volatile("" : "+v"(tid_)); tid_ &= 511;
    const int tid = tid_, wid = __builtin_amdgcn_readfirstlane(tid >> 6), lane = tid & 63, wr = wid >> 2, wc = wid & 3, fr = lane & 15, fq = lane >> 4;
    const int K = g.K, nt = K / BK;
    unsigned voffA[2], voffB[2];
#pragma unroll
    for (int i = 0; i < 2; ++i) { int R, C; stage_rc(tid * 16 + i * 8192, R, C); const int Rb = Epi::PERM ? ((R & ~31) + perm32(R & 31)) : R;
        voffA[i] = (unsigned)(R * K + C) * 2u; voffB[i] = (unsigned)(Rb * K + C) * 2u; }
    const size_t kstep = (size_t)(BK * 2);
    const size_t hstep = (size_t)HALF * K * 2;
    const size_t tstep = 2 * hstep;
    const unsigned ldsw = (unsigned)wid * 1024u;
    const int aoff = lds_byte(wr * 64 + fr, fq * 8), boff = lds_byte(wc * 32 + fr, fq * 8);
#define PG8_SA(b, h) (((b) * 2 + (h)) * HTB)
#define PG8_SB(b, h) ((4 + (b) * 2 + (h)) * HTB)
#define PG8_STAGE(bufoff, gbase, voff) do { _Pragma("unroll") for (int _i = 0; _i < 2; ++_i) \
        __builtin_amdgcn_global_load_lds((const unsigned*)((const char*)(gbase) + (voff)[_i]), (PG8_LAS unsigned*)(lds + (bufoff) + ldsw + _i * 8192), 16, 0, 0); } while (0)
#define PG8_LDA(dst, b, h) do { _Pragma("unroll") for (int m = 0; m < 4; ++m) _Pragma("unroll") for (int k = 0; k < 2; ++k) dst[m][k] = *(const PG8_LAS bf16x8*)(lds + PG8_SA(b, h) + aoff + m * 2048 + k * 1024); } while (0)
#define PG8_LDB(dst, b, h) do { _Pragma("unroll") for (int n = 0; n < 2; ++n) _Pragma("unroll") for (int k = 0; k < 2; ++k) dst[n][k] = *(const PG8_LAS bf16x8*)(lds + PG8_SB(b, h) + boff + n * 2048 + k * 1024); } while (0)
#define PG8_MMA(ai, bj, At, Bt) do { __builtin_amdgcn_s_setprio(1); _Pragma("unroll") for (int m = 0; m < 4; ++m) _Pragma("unroll") for (int n = 0; n < 2; ++n) _Pragma("unroll") for (int k = 0; k < 2; ++k) \
        acc[ai][bj][m][n] = __builtin_amdgcn_mfma_f32_16x16x32_bf16(Bt[n][k], At[m][k], acc[ai][bj][m][n], 0, 0, 0); __builtin_amdgcn_s_setprio(0); } while (0)
#define PG8_WAIT_V(n) asm volatile("s_waitcnt vmcnt(" #n ")" ::: "memory")
#define PG8_WAIT_L(n) asm volatile("s_waitcnt lgkmcnt(" #n ")" ::: "memory")
#define PG8_BAR __builtin_amdgcn_s_barrier()
#define PG8_SCHED __builtin_amdgcn_sched_barrier(0)
    Unit cur, nxt; int ui = 0;
    if (!S.next(0, cur)) return;
    f32x4 acc[2][2][4][2];
#pragma unroll
    for (int a = 0; a < 2; ++a)
#pragma unroll
        for (int b = 0; b < 2; ++b)
#pragma unroll
            for (int m = 0; m < 4; ++m)
#pragma unroll
                for (int n = 0; n < 2; ++n) acc[a][b][m][n] = (f32x4){0.f, 0.f, 0.f, 0.f};
    bf16x8 At[4][2], B0[2][2], B1[2][2];
    const char* cA = (const char*)g.A + (size_t)cur.pm * tstep; const char* cB = (const char*)g.Bt + (size_t)cur.pn * tstep;
    S.a_ready(cur);
    if constexpr (SP2) {
        PG8_STAGE(PG8_SB(0, 0), cB, voffB); PG8_STAGE(PG8_SB(0, 1), cB + hstep, voffB); PG8_STAGE(PG8_SA(0, 0), cA, voffA); PG8_STAGE(PG8_SA(0, 1), cA + hstep, voffA);
        if (wr == 1) PG8_BAR;
        PG8_WAIT_V(2); PG8_BAR;
        PG8_STAGE(PG8_SB(1, 0), cB + kstep, voffB); PG8_STAGE(PG8_SA(1, 0), cA + kstep, voffA); PG8_STAGE(PG8_SB(1, 1), cB + hstep + kstep, voffB);
        PG8_WAIT_V(6); PG8_BAR;
    } else {
        PG8_STAGE(PG8_SB(0, 0), cB, voffB); PG8_STAGE(PG8_SA(0, 0), cA, voffA); PG8_STAGE(PG8_SB(0, 1), cB + hstep, voffB); PG8_STAGE(PG8_SA(0, 1), cA + hstep, voffA);
        if (wr == 1) PG8_BAR;
        PG8_WAIT_V(4); PG8_BAR;
        PG8_STAGE(PG8_SB(1, 0), cB + kstep, voffB); PG8_STAGE(PG8_SA(1, 0), cA + kstep, voffA); PG8_STAGE(PG8_SB(1, 1), cB + hstep + kstep, voffB);
        PG8_WAIT_V(6); PG8_BAR;
    }
    for (;;) {
        const bool has_next = S.next(ui + 1, nxt);
        const char* nA = has_next ? (const char*)g.A + (size_t)nxt.pm * tstep : cA; const char* nB = has_next ? (const char*)g.Bt + (size_t)nxt.pn * tstep : cB;
        for (int t = 0; t < nt; t += 2) {
            const bool last = (t == nt - 2);
            const char* a1 = cA + (size_t)(t + 1) * kstep;
            const char* a2 = last ? nA : cA + (size_t)(t + 2) * kstep; const char* b2 = last ? nB : cB + (size_t)(t + 2) * kstep;
            const char* a3 = a2 + kstep; const char* b3 = b2 + kstep;
            if (last && has_next) S.a_ready(nxt);
            if constexpr (SP2) {
            PG8_LDB(B0, 0, 0); PG8_LDB(B1, 0, 1); PG8_SCHED; PG8_LDA(At, 0, 0); PG8_STAGE(PG8_SA(1, 1), a1 + hstep, voffA);
            PG8_WAIT_V(8); PG8_WAIT_L(0); PG8_BAR; PG8_MMA(0, 0, At, B0); PG8_MMA(0, 1, At, B1); PG8_BAR; PG8_SCHED;
            PG8_LDA(At, 0, 1); PG8_STAGE(PG8_SB(0, 0), b2, voffB); PG8_STAGE(PG8_SB(0, 1), b2 + hstep, voffB); PG8_STAGE(PG8_SA(0, 0), a2, voffA);
            PG8_WAIT_V(8); PG8_WAIT_L(0); PG8_BAR; PG8_MMA(1, 0, At, B0); PG8_MMA(1, 1, At, B1); PG8_BAR; PG8_SCHED;
            PG8_LDB(B0, 1, 0); PG8_LDB(B1, 1, 1); PG8_SCHED; PG8_LDA(At, 1, 0); PG8_STAGE(PG8_SA(0, 1), a2 + hstep, voffA);
            PG8_WAIT_V(8); PG8_WAIT_L(0); PG8_BAR; PG8_MMA(0, 0, At, B0); PG8_MMA(0, 1, At, B1); PG8_BAR; PG8_SCHED;
            PG8_LDA(At, 1, 1); PG8_STAGE(PG8_SB(1, 0), b3, voffB); PG8_STAGE(PG8_SB(1, 1), b3 + hstep, voffB); PG8_STAGE(PG8_SA(1, 0), a3, voffA);
            PG8_WAIT_V(8); PG8_WAIT_L(0); PG8_BAR; PG8_MMA(1, 0, At, B0); PG8_MMA(1, 1, At, B1); PG8_BAR; PG8_SCHED;
            } else {
            PG8_LDB(B0, 0, 0); PG8_SCHED; PG8_LDA(At, 0, 0); PG8_STAGE(PG8_SA(1, 1), a1 + hstep, voffA);
            PG8_WAIT_L(8); PG8_BAR; PG8_WAIT_L(0); PG8_MMA(0, 0, At, B0); PG8_BAR; PG8_SCHED;
            PG8_LDB(B1, 0, 1); PG8_STAGE(PG8_SB(0, 0), b2, voffB);
            PG8_BAR; PG8_WAIT_L(0); PG8_MMA(0, 1, At, B1); PG8_BAR;
            PG8_LDA(At, 0, 1); PG8_STAGE(PG8_SA(0, 0), a2, voffA);
            PG8_BAR; PG8_WAIT_L(0); PG8_MMA(1, 0, At, B0); PG8_BAR; PG8_SCHED;
            PG8_STAGE(PG8_SB(0, 1), b2 + hstep, voffB);
            PG8_WAIT_V(6); PG8_BAR; PG8_MMA(1, 1, At, B1); PG8_BAR;
            PG8_LDB(B0, 1, 0); PG8_SCHED; PG8_LDA(At, 1, 0); PG8_STAGE(PG8_SA(0, 1), a2 + hstep, voffA);
            PG8_WAIT_L(8); PG8_BAR; PG8_WAIT_L(0); PG8_MMA(0, 0, At, B0); PG8_BAR; PG8_SCHED;
            PG8_LDB(B1, 1, 1); PG8_STAGE(PG8_SB(1, 0), b3, voffB);
            PG8_BAR; PG8_WAIT_L(0); PG8_MMA(0, 1, At, B1); PG8_BAR;
            PG8_LDA(At, 1, 1); PG8_STAGE(PG8_SA(1, 0), a3, voffA);
            PG8_BAR; PG8_WAIT_L(0); PG8_MMA(1, 0, At, B0); PG8_BAR; PG8_SCHED;
            PG8_STAGE(PG8_SB(1, 1), b3 + hstep, voffB);
            PG8_WAIT_V(6); PG8_BAR; PG8_MMA(1, 1, At, B1); PG8_BAR;
            }
        }
        if constexpr (ALIGN_EPI) { if (wr == 0) PG8_BAR; }
        if constexpr (!Epi::AFTER_DRAIN) { E(acc, cur, wr, wc, fr, fq); S.done(cur); }
        if (!has_next) break;
#pragma unroll
        for (int a = 0; a < 2; ++a)
#pragma unroll
            for (int b = 0; b < 2; ++b)
#pragma unroll
                for (int m = 0; m < 4; ++m)
#pragma unroll
                    for (int n = 0; n < 2; ++n) acc[a][b][m][n] = (f32x4){0.f, 0.f, 0.f, 0.f};
        cur = nxt; cA = nA; cB = nB; ++ui;
        if constexpr (ALIGN_EPI) { if (wr == 1) PG8_BAR; }
    }
    PG8_WAIT_V(0);
    if constexpr (!ALIGN_EPI) { if (wr == 0) PG8_BAR; }
    PG8_BAR;
    if constexpr (Epi::AFTER_DRAIN) { E.fused(acc, cur, wr, wc, fr, fq, lds, wid, lane); S.done(cur); }
#undef PG8_SA
#undef PG8_SB
#undef PG8_STAGE
#undef PG8_LDA
#undef PG8_LDB
#undef PG8_MMA
#undef PG8_WAIT_V
#undef PG8_WAIT_L
#undef PG8_BAR
#undef PG8_SCHED
}
}
#include <hip/hip_bf16.h>
#include <cmath>
namespace attn_body {
using bf16=__hip_bfloat16;
using bf16x8=__attribute__((ext_vector_type(8)))short;
using s16x4=__attribute__((ext_vector_type(4)))short;
using f32x16=__attribute__((ext_vector_type(16)))float;
using u32x4=__attribute__((ext_vector_type(4)))unsigned;
using f32x4v=__attribute__((ext_vector_type(4)))float;
constexpr int BATCH=4,NHEAD=4,SEQ=8192,D=64,DM=2560,DMO=256;
constexpr int NW=8,QBLK=32,QB=QBLK*NW,KVBLK=64,NQB=SEQ/QB;
constexpr int ATTN_PITCH=DM, ATTN_UNIT_ROWS=QB;
__device__ __forceinline__ int crow(int r,int hi){return (r&3)+8*(r>>2)+4*hi;}
#define SBAR() __builtin_amdgcn_sched_barrier(0)
__device__ __forceinline__ void cmask(f32x16&p0,f32x16&p1,int jb,int qrel,int hi){
  const float NEG=-INFINITY; int kb=64*jb+4*hi;
  #pragma unroll
  for(int r=0;r<16;++r){int kv=kb+(r&3)+8*(r>>2); if(kv>qrel)p0[r]=NEG; if(kv+32>qrel)p1[r]=NEG;}
}

constexpr int NSLOT=3, SLOTB=8192;
constexpr int LDS_K=0, LDS_V=NSLOT*SLOTB, LDS_WS=2*NSLOT*SLOTB, LDS_OST=LDS_WS+NW*64*4, LDS_AUX=LDS_OST+NW*4096, LDS_BYTES=LDS_AUX+32768;
constexpr float C2=0.125f*1.4426950408889634f;
__device__ __forceinline__ void glds16(const void*gsrc,unsigned lds_dst){unsigned keep;
  asm volatile("s_mov_b32 %0, m0\n\ts_mov_b32 m0, %2\n\ts_nop 0\n\tglobal_load_lds_dwordx4 %1, off\n\ts_mov_b32 m0, %0":"=&s"(keep):"v"(gsrc),"s"(lds_dst):"memory");}
__device__ __forceinline__ float max3f(float a,float b,float c){float r;asm("v_max3_f32 %0, %1, %2, %3":"=v"(r):"v"(a),"v"(b),"v"(c));return r;}
__device__ __forceinline__ float max2f(float a,float b){float r;asm("v_max_f32_e32 %0, %1, %2":"=v"(r):"v"(a),"v"(b));return r;}
__device__ __forceinline__ float fadd_s(float a,float b){float r;asm("v_add_f32_e32 %0, %1, %2":"=v"(r):"v"(a),"v"(b));return r;}
__device__ __forceinline__ float fsub_s(float a,float b){float r;asm("v_sub_f32_e32 %0, %1, %2":"=v"(r):"v"(a),"v"(b));return r;}
typedef float f32x2_t __attribute__((ext_vector_type(2))); typedef __bf16 bf16x2_t __attribute__((ext_vector_type(2)));
__device__ __forceinline__ unsigned cvtpk_s(float lo,float hi){f32x2_t v={lo,hi};bf16x2_t b=__builtin_convertvector(v,bf16x2_t);return __builtin_bit_cast(unsigned,b);}
#define WAIT_BAR(N) asm volatile("s_waitcnt vmcnt(" #N ") lgkmcnt(0)\n\ts_barrier":::"memory")

__device__ __forceinline__ void qkt(f32x16&p0,f32x16&p1,const char*Kslot,const bf16x8*qr,int r32,int hi){
  const char*kb=Kslot+hi*1024+r32*16;
  #pragma unroll
  for(int d0=0;d0<4;++d0){
    const bf16x8 b0=*reinterpret_cast<const bf16x8*>(kb+d0*2048);
    const bf16x8 b1=*reinterpret_cast<const bf16x8*>(kb+d0*2048+512);
    {p0=__builtin_amdgcn_mfma_f32_32x32x16_bf16(b0,qr[d0],p0,0,0,0);p1=__builtin_amdgcn_mfma_f32_32x32x16_bf16(b1,qr[d0],p1,0,0,0);}}
}
typedef __attribute__((address_space(3))) const char* lds_cptr;
typedef short v4i16_t __attribute__((ext_vector_type(4)));
__device__ __forceinline__ void kload8(bf16x8*kf,lds_cptr kp){
  kf[0]=*(const __attribute__((address_space(3))) bf16x8*)(kp);      kf[1]=*(const __attribute__((address_space(3))) bf16x8*)(kp+512);
  kf[2]=*(const __attribute__((address_space(3))) bf16x8*)(kp+2048); kf[3]=*(const __attribute__((address_space(3))) bf16x8*)(kp+2560);
  kf[4]=*(const __attribute__((address_space(3))) bf16x8*)(kp+4096); kf[5]=*(const __attribute__((address_space(3))) bf16x8*)(kp+4608);
  kf[6]=*(const __attribute__((address_space(3))) bf16x8*)(kp+6144); kf[7]=*(const __attribute__((address_space(3))) bf16x8*)(kp+6656);
}
__device__ __forceinline__ void kload2(bf16x8*kf,lds_cptr kp,int j){ kf[2*j]=*(const __attribute__((address_space(3))) bf16x8*)(kp+j*2048); kf[2*j+1]=*(const __attribute__((address_space(3))) bf16x8*)(kp+j*2048+512); }
__device__ __forceinline__ s16x4 vtr(lds_cptr p){ return __builtin_bit_cast(s16x4,__builtin_amdgcn_ds_read_tr16_b64_v4i16((__attribute__((address_space(3))) v4i16_t*)p)); }
__device__ __forceinline__ float rowmax(const f32x16&p0,const f32x16&p1){
  float a=max3f(p0[0],p0[1],p1[0]),b=max3f(p0[2],p0[3],p1[1]);a=max3f(a,p1[2],p1[3]);
  #pragma unroll
  for(int r=4;r<16;r+=4){a=max3f(a,p0[r],p0[r+1]);b=max3f(b,p0[r+2],p0[r+3]);a=max3f(a,p1[r],p1[r+1]);b=max3f(b,p1[r+2],p1[r+3]);}
  const float m=max2f(a,b);
  auto rr=__builtin_amdgcn_permlane32_swap(__float_as_uint(m),__float_as_uint(m),false,false);
  return max2f(__uint_as_float(rr[0]),__uint_as_float(rr[1]));
}
__device__ __forceinline__ void pv(f32x16*o,int vb,bf16x8 pa0,bf16x8 pa1,bf16x8 pa2,bf16x8 pa3){
  #pragma unroll
  for(int d0=0;d0<2;++d0){s16x4 lo[4],hi[4];
    #pragma unroll
    for(int ks=0;ks<4;++ks){
      asm volatile("ds_read_b64_tr_b16 %0,%1 offset:%c2":"=&v"(lo[ks]):"v"(vb),"i"(d0*4096+ks*1024):"memory");
      asm volatile("ds_read_b64_tr_b16 %0,%1 offset:%c2":"=&v"(hi[ks]):"v"(vb),"i"(d0*4096+ks*1024+512):"memory");}
    asm volatile("s_waitcnt lgkmcnt(0)":::"memory");SBAR();
    #define PK(k) (bf16x8){lo[k][0],lo[k][1],lo[k][2],lo[k][3],hi[k][0],hi[k][1],hi[k][2],hi[k][3]}
    o[d0]=__builtin_amdgcn_mfma_f32_32x32x16_bf16(pa0,PK(0),o[d0],0,0,0);
    o[d0]=__builtin_amdgcn_mfma_f32_32x32x16_bf16(pa1,PK(1),o[d0],0,0,0);
    o[d0]=__builtin_amdgcn_mfma_f32_32x32x16_bf16(pa2,PK(2),o[d0],0,0,0);
    o[d0]=__builtin_amdgcn_mfma_f32_32x32x16_bf16(pa3,PK(3),o[d0],0,0,0);
    #undef PK
  }
}

#ifndef ATTN_STORE16
#define ATTN_STORE16(p,v) (*(u32x4*)(p)=(v))
#endif
template<int THRL,int MODE> __device__ __forceinline__ void attn_unit(int b,int h,int qb,const bf16*Q,const bf16*__restrict__ K,const bf16*__restrict__ V,bf16*O,const float*__restrict__ aux,int t0,char*shm){
  int tid_=threadIdx.x; asm volatile("":"+v"(tid_));
  const int tid=tid_,lane=tid&63,r32=lane&31,hi=lane>>5; const int wid=__builtin_amdgcn_readfirstlane(tid>>6);
  const long rowbase=(long)b*SEQ; const int q0=qb*QB; const lds_cptr shm3=(lds_cptr)shm;
  const bf16*Qw=Q+(rowbase+q0+wid*QBLK)*DM+h*D;
  const bf16*Kh=K+rowbase*DM+h*D,*Vh=V+rowbase*DM+h*D;
  const unsigned lds0=(unsigned)(uintptr_t)shm;
  float*wsf=(float*)(shm+LDS_WS)+wid*64;
  const bf16*ksrc=Kh+(long)lane*DM+wid*8;
  const bf16*vsrc=Vh+(long)(16*(wid&3)+(lane>>2))*DM+(wid>>2)*32+(lane&3)*8;
  const unsigned kdst=lds0+LDS_K+wid*1024, vdst=lds0+LDS_V+wid*1024;
  #define DMA_K(t,slot) glds16(ksrc+(long)(t)*KVBLK*DM,(unsigned)__builtin_amdgcn_readfirstlane(kdst+(slot)))
  #define DMA_V(t,slot) glds16(vsrc+(long)(t)*KVBLK*DM,(unsigned)__builtin_amdgcn_readfirstlane(vdst+(slot)))
  const int vb0=(int)(lds0+LDS_V)+((lane>>4)&1)*32+(lane&3)*8+(4*hi+((lane&15)>>2))*64;
  const char*Kbase=shm+LDS_K; bf16x8 kf[8];
  const lds_cptr kp0=shm3+LDS_K+hi*1024+r32*16; const lds_cptr vp0=shm3+LDS_V+((lane>>4)&1)*32+(lane&3)*8+(4*hi+((lane&15)>>2))*64;
  const int NT=(q0+QB)/KVBLK;
  typedef __attribute__((address_space(3))) float lds_f32; typedef __attribute__((address_space(3))) f32x4v lds_f32x4;
  lds_f32* const auxl=(lds_f32*)(shm3+LDS_AUX);
  unsigned mbits=0u;
  if(MODE==0){
    const float*src=aux+(long)(b*NHEAD+h)*SEQ;
    for(int i=t0*KVBLK+tid*4;i<q0+QB;i+=NW*64*4) *(lds_f32x4*)(auxl+i)=*(const f32x4v*)(src+i);
    asm volatile("s_waitcnt vmcnt(0) lgkmcnt(0)\n\ts_barrier":::"memory");
  } else {
    const float*src=aux+(long)(b*NHEAD+h)*(NQB*D);
    *(lds_f32x4*)(auxl+tid*4)=*(const f32x4v*)(src+tid*4);
    asm volatile("s_waitcnt vmcnt(0) lgkmcnt(0)\n\ts_barrier":::"memory");
    float qf[32];
    #pragma unroll
    for(int d0=0;d0<4;++d0){ const bf16x8 qv=*reinterpret_cast<const bf16x8*>(&Qw[(long)r32*DM+d0*16+hi*8]);
      #pragma unroll
      for(int j=0;j<8;++j) qf[d0*8+j]=__uint_as_float(((unsigned)(unsigned short)qv[j])<<16); }
    float b1=-INFINITY,b2=-INFINITY,b3=-INFINITY; int i1=-1,i2=-1,i3=-1;
    for(int n=0;n<qb;++n){ const lds_f32* kb=auxl+n*D+hi*8; float sa=0.f,sb=0.f;
      #pragma unroll
      for(int d0=0;d0<4;++d0){ const f32x4v ka=*(const lds_f32x4*)(kb+d0*16), kc=*(const lds_f32x4*)(kb+d0*16+4);
        sa+=qf[d0*8+0]*ka.x; sb+=qf[d0*8+1]*ka.y; sa+=qf[d0*8+2]*ka.z; sb+=qf[d0*8+3]*ka.w;
        sa+=qf[d0*8+4]*kc.x; sb+=qf[d0*8+5]*kc.y; sa+=qf[d0*8+6]*kc.z; sb+=qf[d0*8+7]*kc.w; }
      float s=sa+sb; s+=__shfl_xor(s,32);
      if(s>b1){b3=b2;i3=i2;b2=b1;i2=i1;b1=s;i1=n;} else if(s>b2){b3=b2;i3=i2;b2=s;i2=n;} else if(s>b3){b3=s;i3=n;} }
    mbits=(i1>=0?(1u<<i1):0u)|(i2>=0?(1u<<i2):0u)|(i3>=0?(1u<<i3):0u);
  }
  #define INITC(P0,P1,t) do{ if(MODE==0){ const lds_f32* bp_=auxl+(t)*KVBLK+4*hi; \
      _Pragma("unroll") for(int g_=0;g_<4;++g_){ const f32x4v a_=*(const lds_f32x4*)(bp_+8*g_), c_=*(const lds_f32x4*)(bp_+32+8*g_); \
        P0[4*g_]=a_.x-mhat;P0[4*g_+1]=a_.y-mhat;P0[4*g_+2]=a_.z-mhat;P0[4*g_+3]=a_.w-mhat; P1[4*g_]=c_.x-mhat;P1[4*g_+1]=c_.y-mhat;P1[4*g_+2]=c_.z-mhat;P1[4*g_+3]=c_.w-mhat; } } \
    else { const float nm_=((t)>=NT-4||((mbits>>((t)>>2))&1u))?-mhat:-INFINITY; \
      _Pragma("unroll") for(int r=0;r<16;++r){P0[r]=nm_;P1[r]=nm_;} asm volatile("":"+v"(P0),"+v"(P1)); } }while(0)
  DMA_K(t0,0);DMA_V(t0,0);DMA_K(t0+1,SLOTB);
  bf16x8 qr[4];
  #pragma unroll
  for(int d0=0;d0<4;++d0)qr[d0]=*reinterpret_cast<const bf16x8*>(&Qw[(long)r32*DM+d0*16+hi*8]);
  float mhat=0.f,l_reg=0.f;f32x16 o[2];o[0]=f32x16{};o[1]=f32x16{};
  const int qrel=wid*QBLK+r32;
  #define CMASK(P0,P1,t) do{int jb_=(t)-(NT-4); if(jb_>=0)cmask(P0,P1,jb_,qrel,hi);}while(0)
  bool resc=false;
  #define START(P0,P1) do{ const float rm=rowmax(P0,P1); resc=false; \
    { const float dl=(rm==-INFINITY)?0.f:rm; mhat=fadd_s(mhat,dl); \
      _Pragma("unroll") for(int r=0;r<16;++r){P0[r]=fsub_s(P0[r],dl);P1[r]=fsub_s(P1[r],dl);} \
      } \
    _Pragma("unroll") for(int r=0;r<16;++r)P0[r]=__builtin_amdgcn_exp2f(P0[r]); }while(0)
  #define RESC() do{ if(resc){ asm volatile("s_waitcnt lgkmcnt(0)":::"memory"); \
      _Pragma("unroll") for(int d_=0;d_<2;++d_) _Pragma("unroll") for(int r=0;r<16;++r)o[d_][r]*=wsf[crow(r,hi)]; } }while(0)
  f32x16 pA0,pA1,pB0,pB1;
  int sl_prev=0,sl_cur=0,sl_next=SLOTB;
  #define ROT() do{sl_prev=sl_cur;sl_cur=sl_next;sl_next=(sl_next==(NSLOT-1)*SLOTB)?0:sl_next+SLOTB;}while(0)
  DMA_K(t0+2,2*SLOTB);
  WAIT_BAR(3);
  INITC(pA0,pA1,t0);qkt(pA0,pA1,Kbase,qr,r32,hi);asm volatile("s_nop 15\n\ts_nop 7":"+v"(pA0),"+v"(pA1));CMASK(pA0,pA1,t0);
  START(pA0,pA1);
  _Pragma("unroll") for(int r=0;r<16;++r)pA1[r]=__builtin_amdgcn_exp2f(pA1[r]);
  WAIT_BAR(0);
  DMA_K(t0+3,0);DMA_V(t0+1,SLOTB);
  ROT();
  kload8(kf,kp0+sl_cur);
  WAIT_BAR(2);
  s16x4 vlo[8],vhi[8]; u32x4 pw0,pw1,pw2,pw3;
  #define PKW(P,B) cvtpk_s(P[B],P[B+1])
  #define PAF(k) __builtin_bit_cast(bf16x8,pw##k)
  #define VFR(i) (bf16x8){vlo[i][0],vlo[i][1],vlo[i][2],vlo[i][3],vhi[i][0],vhi[i][1],vhi[i][2],vhi[i][3]}
  #define PIN(x) asm volatile("":"+v"(x))
  #define MX3(a,b,c) __builtin_fmaxf(__builtin_fmaxf((a),(b)),(c))
  #define GAPA(MF,A0,A1,A2,A3,W0,W1,PW) do{ MF; sacc+=A0; sacc+=A1; sacc+=A2; sacc+=A3; PIN(sacc); W0; W1; PIN(PW); SBAR(); }while(0)
  #define EX(v) __builtin_amdgcn_exp2f(v)
  #define GAPB(MF,X,B) do{ MF; X[B]=EX(X[B]); X[B+1]=EX(X[B+1]); X[B+2]=EX(X[B+2]); X[B+3]=EX(X[B+3]); PIN(X); SBAR(); }while(0)
  #define VRD(i) do{ vlo[i]=vtr(vp_+(((i)>>2)*4096+((i)&3)*1024)); vhi[i]=vtr(vp_+(((i)>>2)*4096+((i)&3)*1024+512)); }while(0)
  #define KRD(G,j) do{ if(G){ kload2(kf,kp0+sl_next,j); SBAR(); } }while(0)
  #define STEP(C0,C1,P0,P1,t,GK,GV,GL) do{ SBAR(); INITC(C0,C1,t); SBAR(); \
    const lds_cptr vp_=vp0+sl_prev; \
    VRD(0); SBAR(); float sacc=(P0[0]+P0[1]); \
    GAPA(C0=__builtin_amdgcn_mfma_f32_32x32x16_bf16(kf[0],qr[0],C0,0,0,0), P0[2],P0[3],P0[4],P0[5],     pw0[0]=PKW(P0,0), pw0[1]=PKW(P0,2), pw0); \
    VRD(4); SBAR(); GAPA(C1=__builtin_amdgcn_mfma_f32_32x32x16_bf16(kf[1],qr[0],C1,0,0,0), P0[6],P0[7],P0[8],P0[9],     pw0[2]=PKW(P0,4), pw0[3]=PKW(P0,6), pw0); \
    VRD(1); SBAR(); GAPA(C0=__builtin_amdgcn_mfma_f32_32x32x16_bf16(kf[2],qr[1],C0,0,0,0),   P0[10],P0[11],P0[12],P0[13], pw1[0]=PKW(P0,8), pw1[1]=PKW(P0,10), pw1); \
    VRD(5); SBAR(); GAPA(C1=__builtin_amdgcn_mfma_f32_32x32x16_bf16(kf[3],qr[1],C1,0,0,0),   P0[14],P0[15],P1[0],P1[1],   pw1[2]=PKW(P0,12),pw1[3]=PKW(P0,14), pw1); \
    VRD(2); SBAR(); GAPA(C0=__builtin_amdgcn_mfma_f32_32x32x16_bf16(kf[4],qr[2],C0,0,0,0),   P1[2],P1[3],P1[4],P1[5],     pw2[0]=PKW(P1,0), pw2[1]=PKW(P1,2), pw2); \
    VRD(6); SBAR(); GAPA(C1=__builtin_amdgcn_mfma_f32_32x32x16_bf16(kf[5],qr[2],C1,0,0,0),   P1[6],P1[7],P1[8],P1[9],     pw2[2]=PKW(P1,4), pw2[3]=PKW(P1,6), pw2); \
    VRD(3); SBAR(); GAPA(C0=__builtin_amdgcn_mfma_f32_32x32x16_bf16(kf[6],qr[3],C0,0,0,0),   P1[10],P1[11],P1[12],P1[13], pw3[0]=PKW(P1,8), pw3[1]=PKW(P1,10), pw3); \
    VRD(7); SBAR(); GAPA(C1=__builtin_amdgcn_mfma_f32_32x32x16_bf16(kf[7],qr[3],C1,0,0,0),   P1[14],P1[15],0.f,0.f,       pw3[2]=PKW(P1,12),pw3[3]=PKW(P1,14), pw3); \
    l_reg+=sacc; \
    if(GK){DMA_K((t)+3,sl_cur);} if(GV){DMA_V((t)+1,sl_next);} \
    CMASK(C0,C1,t); \
    { float a=MX3(C0[0],C0[1],C1[0]),b=MX3(C0[2],C0[3],C1[1]); a=MX3(a,C1[2],C1[3]); \
      _Pragma("unroll") for(int r=4;r<16;r+=4){a=MX3(a,C0[r],C0[r+1]);b=MX3(b,C0[r+2],C0[r+3]);a=MX3(a,C1[r],C1[r+1]);b=MX3(b,C1[r+2],C1[r+3]);} \
      float rm=__builtin_fmaxf(a,b); { auto rr=__builtin_amdgcn_permlane32_swap(__float_as_uint(rm),__float_as_uint(rm),false,false); rm=__builtin_fmaxf(__uint_as_float(rr[0]),__uint_as_float(rr[1])); } \
      resc=false; \
      if(__builtin_expect(__any(rm>(float)THRL),0)){ const float dl=__builtin_fmaxf(rm,0.f); mhat+=dl; \
        _Pragma("unroll") for(int r=0;r<16;++r){C0[r]-=dl;C1[r]-=dl;} \
        const float f=__builtin_amdgcn_exp2f(-dl); l_reg*=f; if(hi==0)wsf[r32]=f; resc=true; } } \
    SBAR(); \
    GAPB(o[0]=__builtin_amdgcn_mfma_f32_32x32x16_bf16(PAF(0),VFR(0),o[0],0,0,0), C0,0); \
    GAPB(o[1]=__builtin_amdgcn_mfma_f32_32x32x16_bf16(PAF(0),VFR(4),o[1],0,0,0), C0,4); \
    KRD(GL,0); GAPB(o[0]=__builtin_amdgcn_mfma_f32_32x32x16_bf16(PAF(1),VFR(1),o[0],0,0,0), C0,8); \
    KRD(GL,1); GAPB(o[1]=__builtin_amdgcn_mfma_f32_32x32x16_bf16(PAF(1),VFR(5),o[1],0,0,0), C0,12); \
    KRD(GL,2); GAPB(o[0]=__builtin_amdgcn_mfma_f32_32x32x16_bf16(PAF(2),VFR(2),o[0],0,0,0), C1,0); \
    KRD(GL,3); GAPB(o[1]=__builtin_amdgcn_mfma_f32_32x32x16_bf16(PAF(2),VFR(6),o[1],0,0,0), C1,4); \
    GAPB(o[0]=__builtin_amdgcn_mfma_f32_32x32x16_bf16(PAF(3),VFR(3),o[0],0,0,0), C1,8); \
    GAPB(o[1]=__builtin_amdgcn_mfma_f32_32x32x16_bf16(PAF(3),VFR(7),o[1],0,0,0), C1,12); \
    }while(0)
  int t=t0+1;
  #undef CMASK
  #define CMASK(P0,P1,t) do{}while(0)
  for(;t+5<NT;t+=2){
    STEP(pB0,pB1,pA0,pA1,t,true,true,true);     WAIT_BAR(2); RESC(); ROT();
    STEP(pA0,pA1,pB0,pB1,t+1,true,true,true);   WAIT_BAR(2); RESC(); ROT();
  }
  #undef CMASK
  #define CMASK(P0,P1,t) do{int jb_=(t)-(NT-4); if(jb_>=0)cmask(P0,P1,jb_,qrel,hi);}while(0)
  #define ENDW(tt) do{ if((tt)+3<NT){WAIT_BAR(2);} else if((tt)+2<NT){WAIT_BAR(1);} else {WAIT_BAR(0);} }while(0)
  for(;t+1<NT;t+=2){
    STEP(pB0,pB1,pA0,pA1,t,(t+3<NT),(t+1<NT),(t+1<NT));       ENDW(t);   RESC(); ROT();
    STEP(pA0,pA1,pB0,pB1,t+1,(t+4<NT),(t+2<NT),(t+2<NT));     ENDW(t+1); RESC(); ROT();
  }
  STEP(pB0,pB1,pA0,pA1,NT-1,false,false,false); RESC();
  { float sacc=pB0[0]+pB0[1]; _Pragma("unroll") for(int r=2;r<16;++r)sacc+=pB0[r]; _Pragma("unroll") for(int r=0;r<16;++r)sacc+=pB1[r]; l_reg+=sacc;
    pw0=(u32x4){PKW(pB0,0),PKW(pB0,2),PKW(pB0,4),PKW(pB0,6)};pw1=(u32x4){PKW(pB0,8),PKW(pB0,10),PKW(pB0,12),PKW(pB0,14)};pw2=(u32x4){PKW(pB1,0),PKW(pB1,2),PKW(pB1,4),PKW(pB1,6)};pw3=(u32x4){PKW(pB1,8),PKW(pB1,10),PKW(pB1,12),PKW(pB1,14)};
    SBAR(); pv(o,vb0+sl_cur,PAF(0),PAF(1),PAF(2),PAF(3)); }
  #undef PKW
  #undef PAF
  #undef VFR
  #undef PIN
  #undef MX3
  #undef GAPA
  #undef GAPB
  #undef EX
  #undef VRD
  #undef KRD
  #undef STEP
  #undef ENDW
  {auto rr=__builtin_amdgcn_permlane32_swap(__float_as_uint(l_reg),__float_as_uint(l_reg),false,false);l_reg=__uint_as_float(rr[0])+__uint_as_float(rr[1]);}
  if(hi==0)wsf[32+r32]=l_reg;asm volatile("s_waitcnt lgkmcnt(0)":::"memory");
  float rli[16];
  #pragma unroll
  for(int r=0;r<16;++r)rli[r]=__builtin_amdgcn_rcpf(wsf[32+crow(r,hi)]);
  bf16*Ow=O+(rowbase+q0+wid*QBLK)*DMO+h*D;
  { bf16*stg=(bf16*)(shm+LDS_OST)+wid*2048;
    #pragma unroll
    for(int r=0;r<16;++r){const int orow=crow(r,hi);
      #pragma unroll
      for(int d0=0;d0<2;++d0)stg[orow*64+d0*32+r32]=__float2bfloat16(o[d0][r]*rli[r]);}
    asm volatile("s_waitcnt lgkmcnt(0)":::"memory");
    #pragma unroll
    for(int i=0;i<4;++i){const int row=i*8+(lane>>3),ch=lane&7; const u32x4 v=*(const u32x4*)(stg+row*64+ch*8); ATTN_STORE16(Ow+(long)row*DMO+ch*8,v);} }
  asm volatile("s_waitcnt lgkmcnt(0)\n\ts_barrier":::"memory");
  #undef INITC
  #undef DMA_K
  #undef DMA_V
  #undef CMASK
  #undef START
  #undef RESC
  #undef ROT
}
constexpr int ATTN_LDS_BYTES=LDS_BYTES;
struct AttnTensors { const bf16* P; bf16* Y; const float* kbias; const float* kbar; const float* nrm; };
__device__ __forceinline__ int fox_first_tile(const float* kbias_bh, const float* nrm_bh, int qb, int lane){
  const float qn=nrm_bh[2*qb]; float kn=0.f;
  for(int n=0;n<=qb;++n) kn=fmaxf(kn,nrm_bh[2*n+1]);
  const float thr=kbias_bh[qb*QB]-(2.0f*sqrtf(qn*kn)+160.0f);
  const int NT=(qb*QB+QB)/KVBLK; int first=NT;
  for(int base=0;base<NT;base+=64){ const int t=base+lane; const bool c=(t<NT)&&(kbias_bh[t*KVBLK+KVBLK-1]>thr);
    const unsigned long long m=__ballot(c); if(m){ first=base+__builtin_ctzll(m); break; } }
  first&=~1; if(first>NT-4)first=NT-4; return first;
}
template<int THRL=8> __device__ __forceinline__ void attn_phase(char*lds,const AttnTensors&T,int vcu,int G){
  for(int vc=vcu;vc<256;vc+=G){ const int s=vc&15, bh=vc>>4, b=bh>>2, h=bh&3;
    for(int i=0;i<4;++i){ const int qb=(i&1)?s:31-s;
#ifndef NO_MOBA
      if(i<2) attn_unit<THRL,1>(b,h,qb,T.P+1024,T.P+1280,T.P+1536,T.Y+(long)2*BATCH*SEQ*DMO,T.kbar,0,lds);
#endif
#ifndef NO_FOX
      if(i>=2){ int l_=threadIdx.x; asm volatile("":"+v"(l_)); const int t0=fox_first_tile(T.kbias+(long)bh*SEQ,T.nrm+(long)bh*NQB*2,qb,l_&63);
        attn_unit<THRL,0>(b,h,qb,T.P+1792,T.P+2048,T.P+2304,T.Y+(long)3*BATCH*SEQ*DMO,T.kbias,__builtin_amdgcn_readfirstlane(t0),lds); }
#endif
    } }
}
#undef SBAR
#undef WAIT_BAR
}
constexpr int NWAVES = 8;
constexpr int BATCH = 4, SEQ = 8192, T = BATCH * SEQ, D = 1024, FF = 4096, DEPTH = 4, INW = 6660, NA = 2560, NG = 4096, FCOL = 2560, GCOL = 2564;
constexpr float LN_EPS = 1e-5f, ALPHA = 1.681792830507429f;
constexpr size_t MiB = 1u << 20;
constexpr size_t WS_ADA = 0, WS_KBIAS = 512 * 1024, WS_LOGF = 1 * MiB, WS_KBAR = 1 * MiB + 512 * 1024, WS_ROPE = 2 * MiB;
constexpr size_t WS_WINA = 4 * MiB, WS_WG = 9 * MiB, WS_WB = 17 * MiB, WS_WO = 19 * MiB, WS_WUP = 21 * MiB, WS_WDN = 29 * MiB;
constexpr size_t WS_STATS = 38 * MiB;
constexpr size_t WS_Y = 40 * MiB;
constexpr size_t WS_U = 104 * MiB;
constexpr size_t WS_YB = 168 * MiB;
constexpr size_t WS_U8 = 456 * MiB;
constexpr size_t WS_R1 = 232 * MiB;
constexpr size_t WS_END = 488 * MiB;
constexpr size_t WS_NRM = 1 * MiB + 512 * 1024 + 192 * 1024;
constexpr size_t WS_BAR = 1 * MiB + 768 * 1024, BAR_ZERO_BYTES = 16384;
constexpr int RING_BYTES = 131072, LDS_BYTES = 147456;
typedef unsigned short bf16;
typedef float f32x4 __attribute__((ext_vector_type(4)));
typedef unsigned v4u __attribute__((ext_vector_type(4)));
typedef unsigned v2u __attribute__((ext_vector_type(2)));
__device__ __forceinline__ unsigned f2bf(float f) { unsigned u = __builtin_bit_cast(unsigned, f); return (u + 0x7fffu + ((u >> 16) & 1u)) >> 16; }
__device__ __forceinline__ unsigned pk2(float lo, float hi) { return pg8::cvt_pk_bf16(lo, hi); }
__device__ __forceinline__ float bflo(unsigned w) { return __uint_as_float(w << 16); }
__device__ __forceinline__ float bfhi(unsigned w) { return __uint_as_float(w & 0xffff0000u); }
__device__ __forceinline__ float wave_sum(float v) {
#pragma unroll
    for (int o = 1; o < 64; o <<= 1) v += __shfl_xor(v, o);
    return v;
}
struct Args {
    const float *x, *c; const int* pos; const float *w_ada, *b_ada, *w_in, *b_in, *w_pool, *pool_scale, *conv_w, *w_branch, *w_o, *ln1_g, *ln1_b, *w_up, *b_up, *w_down, *ln2_g, *ln2_b;
    float* out; unsigned char* ws;
};
struct Frame { unsigned char* lds; int tid, lane, wave, vcu, G; };

__device__ __forceinline__ void transpose_item(const float* W, int K, int N, int ldw, bf16* WT, float* scr, int item, int lane) {
    const int nblk = N / 32, kb = item / nblk, nb = item % nblk, k0 = 64 * kb, n0 = 32 * nb;
    float wv_[32];
#pragma unroll
    for (int i = 0; i < 32; ++i) wv_[i] = W[(size_t)(k0 + 2 * i + (lane >> 5)) * ldw + n0 + (lane & 31)];
#pragma unroll
    for (int i = 0; i < 32; ++i) scr[(2 * i + (lane >> 5)) * 33 + (lane & 31)] = wv_[i];
    asm volatile("s_waitcnt lgkmcnt(0)" ::: "memory");
    const int c = lane & 7;
#pragma unroll
    for (int j = 0; j < 4; ++j) { const int n = (lane >> 3) + 8 * j; const float* s = scr + (8 * c) * 33 + n;
        v4u o; o.x = pk2(s[0 * 33], s[1 * 33]); o.y = pk2(s[2 * 33], s[3 * 33]); o.z = pk2(s[4 * 33], s[5 * 33]); o.w = pk2(s[6 * 33], s[7 * 33]);
        *(v4u*)(WT + (size_t)(n0 + n) * K + k0 + 8 * c) = o; }
    asm volatile("s_waitcnt lgkmcnt(0)" ::: "memory");
}
__device__ __forceinline__ void transpose_item8(const float* W, int K, int N, int ldw, unsigned char* WT, float* scr, int item, int lane, float scale) {
    const int nblk = N / 32, kb = item / nblk, nb = item % nblk, k0 = 64 * kb, n0 = 32 * nb;
#pragma unroll 8
    for (int i = 0; i < 32; ++i) { const int kk = 2 * i + (lane >> 5); scr[kk * 33 + (lane & 31)] = W[(size_t)(k0 + kk) * ldw + n0 + (lane & 31)] * scale; }
    asm volatile("s_waitcnt lgkmcnt(0)" ::: "memory");
    const int c = lane & 7;
#pragma unroll
    for (int j = 0; j < 4; ++j) { const int n = (lane >> 3) + 8 * j; const float* s = scr + (8 * c) * 33 + n;
        int w0 = __builtin_amdgcn_cvt_pk_fp8_f32(s[0 * 33], s[1 * 33], 0, false); w0 = __builtin_amdgcn_cvt_pk_fp8_f32(s[2 * 33], s[3 * 33], w0, true);
        int w1 = __builtin_amdgcn_cvt_pk_fp8_f32(s[4 * 33], s[5 * 33], 0, false); w1 = __builtin_amdgcn_cvt_pk_fp8_f32(s[6 * 33], s[7 * 33], w1, true);
        v2u o; o.x = (unsigned)w0; o.y = (unsigned)w1;
        *(v2u*)(WT + (size_t)(n0 + n) * K + k0 + 8 * c) = o; }
    asm volatile("s_waitcnt lgkmcnt(0)" ::: "memory");
}
__device__ __forceinline__ void convert_weights(const Frame& F, const Args& a, int l) {
    float* scr = (float*)(F.lds + F.wave * 16384);
    const int gw = F.vcu * NWAVES + F.wave, NGW = F.G * NWAVES;
    constexpr int I_A = (D / 64) * (NA / 32), I_G = (D / 64) * (NG / 32), I_B = (256 / 64) * (D / 32), I_O = (D / 64) * (D / 32), I_U = (D / 64) * (FF / 32), I_D = (FF / 64) * (D / 32);
    constexpr int NITEMS = I_A + I_G + 4 * I_B + I_O + I_U + I_D;
    const float* win = a.w_in + (size_t)l * D * INW;
    for (int it = gw; it < NITEMS; it += NGW) {
        int r = it;
        if (r < I_A) { transpose_item(win, D, NA, INW, (bf16*)(a.ws + WS_WINA), scr, r, F.lane); continue; } r -= I_A;
        if (r < I_G) { transpose_item(win + GCOL, D, NG, INW, (bf16*)(a.ws + WS_WG), scr, r, F.lane); continue; } r -= I_G;
        if (r < 4 * I_B) { const int n = r / I_B; transpose_item(a.w_branch + ((size_t)l * 4 + n) * 256 * D, 256, D, D, (bf16*)(a.ws + WS_WB) + (size_t)n * D * 256, scr, r % I_B, F.lane); continue; } r -= 4 * I_B;
        if (r < I_O) { transpose_item(a.w_o + (size_t)l * D * D, D, D, D, (bf16*)(a.ws + WS_WO), scr, r, F.lane); continue; } r -= I_O;
        if (r < I_U) { transpose_item(a.w_up + (size_t)l * D * FF, D, FF, FF, (bf16*)(a.ws + WS_WUP), scr, r, F.lane); continue; } r -= I_U;
        transpose_item(a.w_down + (size_t)l * FF * D, FF, D, D, (bf16*)(a.ws + WS_WDN), scr, r, F.lane);
    }
}
__device__ __forceinline__ void sincos_f64(double x, float& sn, float& cs) {
    const double n = rint(x * 0.15915494309189535); double r = x - n * 6.283185307179586;
    const double k = rint(r * 0.6366197723675814); const double y = r - k * 1.5707963267948966;
    const double y2 = y * y;
    const double s = y * (1.0 + y2 * (-1.0 / 6 + y2 * (1.0 / 120 + y2 * (-1.0 / 5040 + y2 * (1.0 / 362880 + y2 * (-1.0 / 39916800 + y2 * (1.0 / 6227020800.0)))))));
    const double c = 1.0 + y2 * (-0.5 + y2 * (1.0 / 24 + y2 * (-1.0 / 720 + y2 * (1.0 / 40320 + y2 * (-1.0 / 3628800 + y2 * (1.0 / 479001600.0 + y2 * (-1.0 / 87178291200.0)))))));
    const int q = ((int)k) & 3;
    const double sr = (q == 0) ? s : (q == 1) ? c : (q == 2) ? -s : -c;
    const double cr = (q == 0) ? c : (q == 1) ? -s : (q == 2) ? -c : s;
    sn = (float)sr; cs = (float)cr;
}
__device__ __forceinline__ void phase_ada(const Frame& F, const Args& a) {
    float* sc = (float*)F.lds;
    if (blockIdx.x < 192) {
        for (int i = F.tid; i < BATCH * D; i += NWAVES * 64) { const float cv = a.c[i]; sc[i] = cv / (1.0f + __builtin_amdgcn_exp2f(-1.4426950408889634f * cv)); }
        __syncthreads();
        const int j = blockIdx.x, l = j / 48, colbase = (j % 48) * 128, cc = F.tid & 127, kq = F.tid >> 7;
        const float* w = a.w_ada + ((size_t)l * D + kq * 256) * (6 * D) + colbase + cc;
        const float* s0 = sc + kq * 256;
        float a0 = 0.f, a1 = 0.f, a2 = 0.f, a3 = 0.f;
#pragma unroll 32
        for (int k = 0; k < 256; ++k) { const float wv = w[(size_t)k * (6 * D)]; a0 += s0[k] * wv; a1 += s0[D + k] * wv; a2 += s0[2 * D + k] * wv; a3 += s0[3 * D + k] * wv; }
        float* red = sc + BATCH * D;
        red[(kq * 4 + 0) * 128 + cc] = a0; red[(kq * 4 + 1) * 128 + cc] = a1; red[(kq * 4 + 2) * 128 + cc] = a2; red[(kq * 4 + 3) * 128 + cc] = a3;
        __syncthreads();
        { const int b = F.tid >> 7; const float v = red[(0 * 4 + b) * 128 + cc] + red[(1 * 4 + b) * 128 + cc] + red[(2 * 4 + b) * 128 + cc] + red[(3 * 4 + b) * 128 + cc] + a.b_ada[l * 6 * D + colbase + cc];
          ((float*)(a.ws + WS_ADA))[(size_t)(l * BATCH + b) * 6 * D + colbase + cc] = v; }
        __syncthreads();
    }
    { const int gt = blockIdx.x * (NWAVES * 64) + F.tid, GT = F.G * NWAVES * 64; float* rope = (float*)(a.ws + WS_ROPE);
      for (int idx = gt; idx < T * 8; idx += GT) { const int t = idx >> 3, i = idx & 7;
          const float inv = (i == 0) ? 1.0f : (i == 1) ? 0.1939227432012558f : (i == 2) ? 0.03760603070259094f : (i == 3) ? 0.007292664609849453f : (i == 4) ? 0.0014142135623842478f : (i == 5) ? 0.00027424818836152554f : (i == 6) ? 5.318296098266728e-05f : 1.0313386155758053e-05f;
          const float ang = (float)a.pos[t] * inv; float sn, cs; sincos_f64((double)ang, sn, cs);
          rope[(size_t)t * 16 + i] = cs; rope[(size_t)t * 16 + 8 + i] = sn; } }
    convert_weights(F, a, 0);
}
__device__ __forceinline__ void phase_ln(const Frame& F, const Args& a, const float* in, float* xout, const float* lng, const float* lnb, const float* ada_sh, const float* ada_sc, bf16* U, int wf_l, float* stats_out = nullptr, const bf16* in16 = nullptr, unsigned char* U8 = nullptr) {
    float* wf = (float*)F.lds;
    if (wf_l >= 0) { const float* src = a.w_in + (size_t)wf_l * D * INW + FCOL;
        for (int i = F.tid; i < D; i += NWAVES * 64) *(f32x4*)(wf + 4 * i) = *(const f32x4*)(src + (size_t)i * INW);
        __syncthreads(); }
    const int gw = F.vcu * NWAVES + F.wave, NGW = F.G * NWAVES;
    if (stats_out && gw == 0) {
#pragma unroll
        for (int j = 0; j < 4; ++j) { *((f32x4*)(stats_out + 2 * T) + F.lane + 64 * j) = *((const f32x4*)lng + F.lane + 64 * j) * ALPHA; *((f32x4*)(stats_out + 2 * T + D) + F.lane + 64 * j) = *((const f32x4*)lnb + F.lane + 64 * j) * ALPHA; } }
    for (int m0 = gw; m0 < T; m0 += 2 * NGW) {
        f32x4 vv[2][4];
#pragma unroll
        for (int h = 0; h < 2; ++h) { const int m = m0 + h * NGW; if (m < T) {
            if (in16) { const v2u* xr = (const v2u*)(in16 + (size_t)m * D) + F.lane;
#pragma unroll
                for (int j = 0; j < 4; ++j) { const v2u q = xr[64 * j]; vv[h][j] = (f32x4){bflo(q.x), bfhi(q.x), bflo(q.y), bfhi(q.y)}; } }
            else { const f32x4* xr = (const f32x4*)(in + (size_t)m * D) + F.lane;
#pragma unroll
                for (int j = 0; j < 4; ++j) vv[h][j] = xr[64 * j]; } } }
#pragma unroll
        for (int h = 0; h < 2; ++h) { const int m = m0 + h * NGW; if (m >= T) break;
        f32x4 v[4];
#pragma unroll
        for (int j = 0; j < 4; ++j) v[j] = vv[h][j];
        if (lng) {
            float s = 0.f;
#pragma unroll
            for (int j = 0; j < 4; ++j) s += (v[j].x + v[j].y) + (v[j].z + v[j].w);
            const float mean = wave_sum(s) * (1.f / D); float s2 = 0.f;
#pragma unroll
            for (int j = 0; j < 4; ++j) { v[j] = v[j] - mean; s2 += (v[j].x * v[j].x + v[j].y * v[j].y) + (v[j].z * v[j].z + v[j].w * v[j].w); }
            const float rstd = 1.f / sqrtf(wave_sum(s2) * (1.f / D) + LN_EPS);
            if (stats_out && F.lane == 0) { stats_out[2 * (size_t)m] = mean; stats_out[2 * (size_t)m + 1] = rstd; }
#pragma unroll
            for (int j = 0; j < 4; ++j) { const f32x4 g = *((const f32x4*)lng + F.lane + 64 * j), bb = *((const f32x4*)lnb + F.lane + 64 * j); v[j] = v[j] * rstd * g + bb; }
            if (xout) { f32x4* xo = (f32x4*)(xout + (size_t)m * D) + F.lane;
#pragma unroll
                for (int j = 0; j < 4; ++j) xo[64 * j] = v[j]; }
        }
        if (U) {
            const int b = m >> 13;
            float s = 0.f;
#pragma unroll
            for (int j = 0; j < 4; ++j) s += (v[j].x + v[j].y) + (v[j].z + v[j].w);
            const float mean = wave_sum(s) * (1.f / D); float s2 = 0.f;
#pragma unroll
            for (int j = 0; j < 4; ++j) { v[j] = v[j] - mean; s2 += (v[j].x * v[j].x + v[j].y * v[j].y) + (v[j].z * v[j].z + v[j].w * v[j].w); }
            const float rstd = 1.f / sqrtf(wave_sum(s2) * (1.f / D) + LN_EPS);
            const f32x4* scp = (const f32x4*)(ada_sc + (size_t)b * 6 * D) + F.lane; const f32x4* shp = (const f32x4*)(ada_sh + (size_t)b * 6 * D) + F.lane;
            unsigned long long* o8 = (unsigned long long*)(U + (size_t)m * D) + F.lane;
            f32x4 fa = (f32x4){0.f, 0.f, 0.f, 0.f};
#pragma unroll
            for (int j = 0; j < 4; ++j) { const f32x4 scv = scp[64 * j], shv = shp[64 * j]; v[j] = v[j] * rstd * (scv + 1.0f) + shv;
                o8[64 * j] = (unsigned long long)pk2(v[j].x, v[j].y) | ((unsigned long long)pk2(v[j].z, v[j].w) << 32);
                if (U8) { int w8 = __builtin_amdgcn_cvt_pk_fp8_f32(v[j].x, v[j].y, 0, false); w8 = __builtin_amdgcn_cvt_pk_fp8_f32(v[j].z, v[j].w, w8, true); ((unsigned*)(U8 + (size_t)m * D))[F.lane + 64 * j] = (unsigned)w8; }
                if (wf_l >= 0) { const f32x4* wp = (const f32x4*)(wf + 4 * (4 * F.lane + 256 * j)); fa += wp[0] * v[j].x + wp[1] * v[j].y + wp[2] * v[j].z + wp[3] * v[j].w; } }
            if (wf_l >= 0) {
                fa.x = wave_sum(fa.x); fa.y = wave_sum(fa.y); fa.z = wave_sum(fa.z); fa.w = wave_sum(fa.w);
                if (F.lane < 4) { float z = (F.lane == 0) ? fa.x : (F.lane == 1) ? fa.y : (F.lane == 2) ? fa.z : fa.w; z += a.b_in[(size_t)wf_l * INW + FCOL + F.lane];
                    const float ls = fminf(z, 0.f) - 0.6931471805599453f * __builtin_amdgcn_logf(1.0f + __builtin_amdgcn_exp2f(-1.4426950408889634f * fabsf(z)));
                    ((float*)(a.ws + WS_LOGF))[(size_t)(b * 4 + F.lane) * SEQ + (m & (SEQ - 1))] = ls; }
            }
        }
            }
    }
    __syncthreads();
}
__device__ __forceinline__ void phase_prep(const Frame& F, const Args& a, int l) {
    bf16* P = (bf16*)(a.ws + WS_R1); bf16* Y = (bf16*)(a.ws + WS_Y); const float* rope = (const float*)(a.ws + WS_ROPE);
    const int tid = F.tid;
    { float* red = (float*)F.lds; float* red2 = red + 256 * 65;
      for (int item = blockIdx.x; item < 512; item += F.G) {
        const int tb = item >> 2, h = item & 3, i = tid & 255, which = tid >> 8; const size_t row = (size_t)tb * 256 + i;
        bf16* p = P + row * NA + 1024 + which * 256 + h * 64;
        const v4u c0 = *(const v4u*)p, c1 = *(const v4u*)(p + 8);
        float t1[8] = {bflo(c0.x), bfhi(c0.x), bflo(c0.y), bfhi(c0.y), bflo(c0.z), bfhi(c0.z), bflo(c0.w), bfhi(c0.w)};
        float t2[8] = {bflo(c1.x), bfhi(c1.x), bflo(c1.y), bfhi(c1.y), bflo(c1.z), bfhi(c1.z), bflo(c1.w), bfhi(c1.w)};
        const f32x4 cA = *(const f32x4*)(rope + row * 16), cB = *(const f32x4*)(rope + row * 16 + 4), sA = *(const f32x4*)(rope + row * 16 + 8), sB = *(const f32x4*)(rope + row * 16 + 12);
        const float cs[8] = {cA.x, cA.y, cA.z, cA.w, cB.x, cB.y, cB.z, cB.w}, sn[8] = {sA.x, sA.y, sA.z, sA.w, sB.x, sB.y, sB.z, sB.w};
        float r1[8], r2[8];
#pragma unroll
        for (int d = 0; d < 8; ++d) { r1[d] = t1[d] * cs[d] - t2[d] * sn[d]; r2[d] = t2[d] * cs[d] + t1[d] * sn[d]; }
        v4u o0, o1; o0.x = pk2(r1[0], r1[1]); o0.y = pk2(r1[2], r1[3]); o0.z = pk2(r1[4], r1[5]); o0.w = pk2(r1[6], r1[7]);
        o1.x = pk2(r2[0], r2[1]); o1.y = pk2(r2[2], r2[3]); o1.z = pk2(r2[4], r2[5]); o1.w = pk2(r2[6], r2[7]);
        *(v4u*)p = o0; *(v4u*)(p + 8) = o1;
        if (which == 1) {
            float* rr = red + i * 65;
#pragma unroll
            for (int d = 0; d < 8; ++d) { rr[d] = r1[d]; rr[8 + d] = r2[d]; }
#pragma unroll
            for (int ch = 2; ch < 8; ++ch) { const v4u cv = *(const v4u*)(p + 8 * ch);
                rr[8 * ch + 0] = bflo(cv.x); rr[8 * ch + 1] = bfhi(cv.x); rr[8 * ch + 2] = bflo(cv.y); rr[8 * ch + 3] = bfhi(cv.y);
                rr[8 * ch + 4] = bflo(cv.z); rr[8 * ch + 5] = bfhi(cv.z); rr[8 * ch + 6] = bflo(cv.w); rr[8 * ch + 7] = bfhi(cv.w); }
        }
        {
          const bf16* pf = P + row * NA + 1792 + which * 256 + h * 64; float ss = 0.f;
#pragma unroll
          for (int ch = 0; ch < 8; ++ch) { const v4u cv = *(const v4u*)(pf + 8 * ch);
              ss += bflo(cv.x) * bflo(cv.x) + bfhi(cv.x) * bfhi(cv.x) + bflo(cv.y) * bflo(cv.y) + bfhi(cv.y) * bfhi(cv.y) + bflo(cv.z) * bflo(cv.z) + bfhi(cv.z) * bfhi(cv.z) + bflo(cv.w) * bflo(cv.w) + bfhi(cv.w) * bfhi(cv.w); }
#pragma unroll
          for (int o = 1; o < 64; o <<= 1) ss = fmaxf(ss, __shfl_xor(ss, o));
          if (F.lane == 0) red2[512 + F.wave] = ss; }
        __syncthreads();
        { const int col = tid & 63, part = tid >> 6; float s = 0.f;
          for (int r = 0; r < 32; ++r) s += red[(part * 32 + r) * 65 + col];
          red2[part * 64 + col] = s; }
        __syncthreads();
        if (tid < 64) { float s = 0.f;
#pragma unroll
            for (int pp = 0; pp < 8; ++pp) s += red2[pp * 64 + tid];
            ((float*)(a.ws + WS_KBAR))[((size_t)((tb >> 5) * 4 + h) * 32 + (tb & 31)) * 64 + tid] = s * (1.0f / 256.0f);
            if (tid < 2) ((float*)(a.ws + WS_NRM))[((size_t)((tb >> 5) * 4 + h) * 32 + (tb & 31)) * 2 + tid] = fmaxf(fmaxf(red2[512 + 4 * tid], red2[512 + 4 * tid + 1]), fmaxf(red2[512 + 4 * tid + 2], red2[512 + 4 * tid + 3])) * 1.02f; }
        __syncthreads();
      } }
    { double* ds = (double*)F.lds;
      for (int seq = blockIdx.x; seq < 16; seq += F.G) {
        const float* lf = (const float*)(a.ws + WS_LOGF) + (size_t)seq * SEQ + 16 * tid; float* kb = (float*)(a.ws + WS_KBIAS) + (size_t)seq * SEQ + 16 * tid;
        f32x4 q[4];
#pragma unroll
        for (int j = 0; j < 4; ++j) q[j] = *(const f32x4*)(lf + 4 * j);
        double tot = 0.0;
#pragma unroll
        for (int j = 0; j < 4; ++j) tot += ((double)q[j].x + (double)q[j].y) + ((double)q[j].z + (double)q[j].w);
        double inc = tot;
#pragma unroll
        for (int o = 1; o < 64; o <<= 1) { const double up = __shfl_up(inc, o); if (F.lane >= o) inc += up; }
        if (F.lane == 63) ds[F.wave] = inc;
        __syncthreads();
        double run = inc - tot;
        for (int j = 0; j < F.wave; ++j) run += ds[j];
#pragma unroll
        for (int j = 0; j < 4; ++j) { f32x4 o; run += (double)q[j].x; o.x = (float)(run * -1.4426950408889634); run += (double)q[j].y; o.y = (float)(run * -1.4426950408889634);
            run += (double)q[j].z; o.z = (float)(run * -1.4426950408889634); run += (double)q[j].w; o.w = (float)(run * -1.4426950408889634); *(f32x4*)(kb + 4 * j) = o; }
        __syncthreads();
      } }
    { float* WP = (float*)F.lds; float* PL = WP + 4 * 64 * 64;
      const float* wpg = a.w_pool + (size_t)l * 4 * 64 * 64;
      for (int i = tid; i < 4 * 64 * 64 / 4; i += NWAVES * 64) *(f32x4*)(WP + 4 * i) = *(const f32x4*)(wpg + 4 * i);
      const int ch = tid & 255, half = tid >> 8, g = ch >> 6, w = 2 << g;
      const float pscale = a.pool_scale[l * 256 + ch];
      for (int item = blockIdx.x; item < T / 32; item += F.G) {
        const int row0 = item * 32 + half * 16, s0 = row0 & (SEQ - 1);
        float vals[31];
#pragma unroll
        for (int j = 0; j < 31; ++j) { const int sj = s0 - 15 + j; vals[j] = (sj >= 0) ? __uint_as_float(((unsigned)P[(size_t)(row0 - 15 + j) * NA + ch]) << 16) : 0.f; }
#pragma unroll
        for (int tt = 0; tt < 16; ++tt) { float sum = 0.f;
#pragma unroll
            for (int dd = 0; dd < 16; ++dd) if (dd < w) sum += vals[15 + tt - dd];
            const int cnt = min(s0 + tt + 1, w);
            PL[(half * 16 + tt) * 256 + ch] = sum * __builtin_amdgcn_rcpf((float)cnt) - vals[15 + tt]; }
        __syncthreads();
        { const int cq = tid & 63, tg = tid >> 6, g2 = cq >> 4, d0 = 4 * (cq & 15);
          f32x4 acc4[4];
#pragma unroll
          for (int t = 0; t < 4; ++t) acc4[t] = (f32x4){0.f, 0.f, 0.f, 0.f};
          const float* wb = WP + g2 * 4096 + d0; const float* pb = PL + (4 * tg) * 256 + g2 * 64;
          for (int c = 0; c < 64; c += 4) {
              const f32x4 w0 = *(const f32x4*)(wb + c * 64), w1 = *(const f32x4*)(wb + (c + 1) * 64), w2 = *(const f32x4*)(wb + (c + 2) * 64), w3 = *(const f32x4*)(wb + (c + 3) * 64);
#pragma unroll
              for (int t = 0; t < 4; ++t) { const f32x4 pv = *(const f32x4*)(pb + t * 256 + c); acc4[t] += w0 * pv.x + w1 * pv.y + w2 * pv.z + w3 * pv.w; } }
          const f32x4 ps = *(const f32x4*)(a.pool_scale + l * 256 + 4 * cq);
#pragma unroll
          for (int t = 0; t < 4; ++t) { const f32x4 o = acc4[t] * ps; v2u ov; ov.x = pk2(o.x, o.y); ov.y = pk2(o.z, o.w);
              *(v2u*)(Y + (size_t)(item * 32 + 4 * tg + t) * 256 + 4 * cq) = ov; } }
        __syncthreads();
      } }
    { bf16* Yc = Y + (size_t)T * 256; const float* cw = a.conv_w + (size_t)l * 3 * 256;
      const int gt = blockIdx.x * (NWAVES * 64) + tid, GT = F.G * NWAVES * 64; const int oc = (gt & 31) * 8;
      f32x4 cwv[3][2];
#pragma unroll
      for (int k = 0; k < 3; ++k) { cwv[k][0] = *(const f32x4*)(cw + k * 256 + oc); cwv[k][1] = *(const f32x4*)(cw + k * 256 + oc + 4); }
      for (int idx = gt; idx < (T / 4) * 32; idx += GT) { const int row0 = (idx >> 5) * 4, s0 = row0 & (SEQ - 1);
        const bf16* p = P + (size_t)row0 * NA + oc;
        v4u cc[6], hh[6], bb[4];
#pragma unroll
        for (int j = 0; j < 6; ++j) { if (s0 + j - 2 >= 0) { cc[j] = *(const v4u*)(p + (ptrdiff_t)(j - 2) * NA + 512); hh[j] = *(const v4u*)(p + (ptrdiff_t)(j - 2) * NA + 768); }
                                      else { cc[j] = (v4u){0u, 0u, 0u, 0u}; hh[j] = (v4u){0u, 0u, 0u, 0u}; } }
#pragma unroll
        for (int t = 0; t < 4; ++t) bb[t] = *(const v4u*)(p + (size_t)t * NA + 256);
        float v[6][8];
#pragma unroll
        for (int j = 0; j < 6; ++j) { v[j][0] = bflo(cc[j].x) * bflo(hh[j].x); v[j][1] = bfhi(cc[j].x) * bfhi(hh[j].x); v[j][2] = bflo(cc[j].y) * bflo(hh[j].y); v[j][3] = bfhi(cc[j].y) * bfhi(hh[j].y);
                                      v[j][4] = bflo(cc[j].z) * bflo(hh[j].z); v[j][5] = bfhi(cc[j].z) * bfhi(hh[j].z); v[j][6] = bflo(cc[j].w) * bflo(hh[j].w); v[j][7] = bfhi(cc[j].w) * bfhi(hh[j].w); }
#pragma unroll
        for (int t = 0; t < 4; ++t) { float z[8];
#pragma unroll
            for (int e = 0; e < 8; ++e) { const float w0 = e < 4 ? cwv[0][0][e] : cwv[0][1][e - 4], w1 = e < 4 ? cwv[1][0][e] : cwv[1][1][e - 4], w2 = e < 4 ? cwv[2][0][e] : cwv[2][1][e - 4];
                z[e] = w0 * v[t][e] + w1 * v[t + 1][e] + w2 * v[t + 2][e]; }
            const v4u b4 = bb[t];
            v4u o; o.x = pk2(z[0] * bflo(b4.x), z[1] * bfhi(b4.x)); o.y = pk2(z[2] * bflo(b4.y), z[3] * bfhi(b4.y)); o.z = pk2(z[4] * bflo(b4.z), z[5] * bfhi(b4.z)); o.w = pk2(z[6] * bflo(b4.w), z[7] * bfhi(b4.w));
            *(v4u*)(Yc + (size_t)(row0 + t) * 256 + oc) = o; } } }
    __syncthreads();
}
typedef short mbf16x8 __attribute__((ext_vector_type(8)));
typedef float mf32x16 __attribute__((ext_vector_type(16)));
__device__ __forceinline__ void phase_merge(const Frame& F, const bf16* Y, const bf16* WB, const unsigned char* G, bf16* Mout) {
    unsigned char* lb = F.lds;
    const int tid = F.tid, lane = F.lane, w = F.wave, i32 = lane & 31, hi = lane >> 5;
    for (int unit = F.vcu; unit < (T / 256) * (D / 128); unit += F.G) {
        const int pm = unit >> 3, pn = unit & 7, c0 = pn * 128; const size_t row = (size_t)pm * 256 + w * 32 + i32;
        mf32x16 sum[4];
#pragma unroll
        for (int cb = 0; cb < 4; ++cb)
#pragma unroll
            for (int r = 0; r < 16; ++r) sum[cb][r] = 0.f;
        for (int n = 0; n < 4; ++n) {
            const bf16* yp = Y + ((size_t)n * T + row) * 256 + 8 * hi;
            mbf16x8 yf[16];
#pragma unroll
            for (int ks = 0; ks < 16; ++ks) yf[ks] = *(const mbf16x8*)(yp + 16 * ks);
            __syncthreads();
            { const unsigned char* wp = (const unsigned char*)(WB + ((size_t)n * D + c0) * 256);
              v4u tmp[8];
#pragma unroll
              for (int i = 0; i < 8; ++i) tmp[i] = *(const v4u*)(wp + (size_t)(tid + 512 * i) * 16);
#pragma unroll
              for (int i = 0; i < 8; ++i) { const int q = tid + 512 * i; *(v4u*)(lb + (q >> 5) * 528 + (q & 31) * 16) = tmp[i]; } }
            __syncthreads();
            mf32x16 acc[4];
#pragma unroll
            for (int cb = 0; cb < 4; ++cb)
#pragma unroll
                for (int r = 0; r < 16; ++r) acc[cb][r] = 0.f;
            const unsigned char* lrow = lb + i32 * 528 + 16 * hi;
#pragma unroll
            for (int ks = 0; ks < 16; ++ks)
#pragma unroll
                for (int cb = 0; cb < 4; ++cb) { const mbf16x8 wf = *(const mbf16x8*)(lrow + cb * 32 * 528 + 32 * ks);
                    acc[cb] = __builtin_amdgcn_mfma_f32_32x32x16_bf16(wf, yf[ks], acc[cb], 0, 0, 0); }
            const unsigned char* gp = G + ((size_t)n * T + row) * D + c0 + 4 * hi;
#pragma unroll
            for (int cb = 0; cb < 4; ++cb)
#pragma unroll
                for (int g = 0; g < 4; ++g) { const unsigned gw = *(const unsigned*)(gp + 32 * cb + 8 * g);
                    sum[cb][4 * g + 0] += acc[cb][4 * g + 0] * (float)(gw & 255u); sum[cb][4 * g + 1] += acc[cb][4 * g + 1] * (float)((gw >> 8) & 255u);
                    sum[cb][4 * g + 2] += acc[cb][4 * g + 2] * (float)((gw >> 16) & 255u); sum[cb][4 * g + 3] += acc[cb][4 * g + 3] * (float)(gw >> 24); }
        }
        bf16* mp = Mout + row * D + c0 + 4 * hi;
#pragma unroll
        for (int cb = 0; cb < 4; ++cb)
#pragma unroll
            for (int g = 0; g < 4; ++g) { const float q = 1.0f / 255.0f; v2u o; o.x = pk2(sum[cb][4 * g + 0] * q, sum[cb][4 * g + 1] * q); o.y = pk2(sum[cb][4 * g + 2] * q, sum[cb][4 * g + 3] * q); *(v2u*)(mp + 32 * cb + 8 * g) = o; }
    }
    __syncthreads();
}
#ifdef PROBE
__device__ __forceinline__ void probe_dump(float* out, const bf16* src, int pitch, const float* small, int nsmall) {
    const size_t gt = (size_t)blockIdx.x * 512 + threadIdx.x, GT = (size_t)gridDim.x * 512;
    for (size_t i = gt; i < (size_t)T * D; i += GT) { const size_t row = i >> 10; const int c = (int)(i & 1023); float s = 0.f;
        for (int j = c; j < pitch; j += 1024) s += __uint_as_float(((unsigned)src[row * pitch + j]) << 16);
        if (small) s += small[i % nsmall];
        out[i] = s; }
}
#endif
#define LAS __attribute__((address_space(3)))
#define XB_TMO      128
#define XB_XCNT(j)  (256  + 64 * (j))
#define XB_XSUB(j)  (1280 + 64 * (j))
#define XB_XGEN(j)  (2304 + 64 * (j))
#define XB_TOP      3328
#define XB_TOPGEN   3392
#define XCD_BAR_WORDS 3456
#define XB_SPIN_CAP (1u << 18)

__device__ __forceinline__ unsigned xb_ld(unsigned* p)              { return __hip_atomic_load(p, __ATOMIC_RELAXED, __HIP_MEMORY_SCOPE_AGENT); }
__device__ __forceinline__ unsigned xb_add(unsigned* p, unsigned v) { return __hip_atomic_fetch_add(p, v, __ATOMIC_RELAXED, __HIP_MEMORY_SCOPE_AGENT); }
__device__ __forceinline__ unsigned xb_xcc_id() { return (unsigned)__builtin_amdgcn_s_getreg((3 << 11) | 20) & 0xFu; }
#define XB_SPIN(cond, bar) do { unsigned _sp = 0; while (cond) { __builtin_amdgcn_s_sleep(1); \
    if ((++_sp & 255u) == 0u) { if (xb_ld(&(bar)[XB_TMO])) break; if (_sp > XB_SPIN_CAP) { atomicAdd(&(bar)[XB_TMO], 1u); break; } } } } while (0)

struct XcdBarrier {
    unsigned* bar; unsigned x;
    volatile LAS unsigned* st;
};

__device__ __forceinline__ XcdBarrier xcd_barrier_post(unsigned* bar, volatile LAS unsigned* st) {
    XcdBarrier b; b.bar = bar; b.x = xb_xcc_id(); b.st = st;
    if (threadIdx.x == 0) (void)xb_add(&bar[XB_XCNT(b.x)], 1u);
    return b;
}
__device__ __forceinline__ void xcd_barrier_complete(unsigned* bar, unsigned x, unsigned& nloc, unsigned& nx) {
    const unsigned G = gridDim.x * gridDim.y * gridDim.z;
    unsigned sum, cnt, mine, sp = 0u;
    for (;;) {
        sum = 0u; cnt = 0u; mine = 0u;
#pragma unroll
        for (unsigned j = 0; j < 16; ++j) { const unsigned c = xb_ld(&bar[XB_XCNT(j)]); sum += c; cnt += (c > 0u) ? 1u : 0u; mine = (j == x) ? c : mine; }
        if (sum == G) break;
        __builtin_amdgcn_s_sleep(1);
        if ((++sp & 255u) == 0u) { if (xb_ld(&bar[XB_TMO])) break; if (sp > XB_SPIN_CAP) { atomicAdd(&bar[XB_TMO], 1u); break; } }
    }
    nloc = mine > 0u ? mine : 1u; nx = cnt > 0u ? cnt : 1u;
}

__device__ __forceinline__ void xcd_barrier(const XcdBarrier& b) {
    asm volatile("s_waitcnt vmcnt(0)" ::: "memory");
    __syncthreads();
    if (threadIdx.x == 0) {
        unsigned* bar = b.bar;
        __builtin_amdgcn_s_waitcnt(0);
        unsigned nloc = b.st[0], nx = b.st[1];
        if (nloc == 0u) { xcd_barrier_complete(bar, b.x, nloc, nx); b.st[0] = nloc; b.st[1] = nx; }
        const unsigned old = xb_add(&bar[XB_XSUB(b.x)], 1u);
        const unsigned gen = old / nloc;
        if (old + 1u == (gen + 1u) * nloc) {
            __builtin_amdgcn_fence(__ATOMIC_RELEASE, "agent");
            asm volatile("s_waitcnt vmcnt(0)" ::: "memory");
            const unsigned og = xb_add(&bar[XB_TOP], 1u);
            const unsigned tg = og / nx;
            if (og + 1u == (tg + 1u) * nx) xb_add(&bar[XB_TOPGEN], 1u);
            else XB_SPIN(xb_ld(&bar[XB_TOPGEN]) == tg, bar);
            __builtin_amdgcn_fence(__ATOMIC_ACQUIRE, "agent");
            xb_add(&bar[XB_XGEN(b.x)], 1u);
            asm volatile("s_waitcnt vmcnt(0)" ::: "memory");
        } else {
            XB_SPIN(xb_ld(&bar[XB_XGEN(b.x)]) == gen, bar);
            __builtin_amdgcn_fence(__ATOMIC_ACQUIRE, "agent");
            asm volatile("s_waitcnt vmcnt(0)" ::: "memory");
        }
    }
    __syncthreads();
}
constexpr int ARGV_OFF = RING_BYTES + 1024;
#define ARG_LIST(X) X(0, x) X(1, c) X(2, pos) X(3, w_ada) X(4, b_ada) X(5, w_in) X(6, b_in) X(7, w_pool) X(8, pool_scale) X(9, conv_w) X(10, w_branch) X(11, w_o) X(12, ln1_g) X(13, ln1_b) X(14, w_up) X(15, b_up) X(16, w_down) X(17, ln2_g) X(18, ln2_b) X(19, out) X(20, ws)
typedef __attribute__((address_space(3))) volatile unsigned lds_vu32;
template <class Tp> __device__ __forceinline__ Tp* ldarg(lds_vu32* argv, int i) {
    const unsigned lo = __builtin_amdgcn_readfirstlane(argv[2 * i]), hi = __builtin_amdgcn_readfirstlane(argv[2 * i + 1]);
    typedef __attribute__((address_space(1))) Tp* gptr_t;
    return (Tp*)(gptr_t)(((unsigned long long)hi << 32) | lo);
}
__device__ __forceinline__ Args load_args(lds_vu32* argv) {
    Args a;
#define X(i, name) a.name = ldarg<typename std::remove_pointer<decltype(a.name)>::type>(argv, i);
    ARG_LIST(X)
#undef X
    return a;
}
__global__ void __launch_bounds__(NWAVES * 64, 2) fwd_megakernel(Args a0) {
    extern __shared__ __attribute__((aligned(16))) unsigned char lds[];
    cg::grid_group grid = cg::this_grid();
    lds_vu32* argv = (lds_vu32*)(unsigned)ARGV_OFF;
    if (threadIdx.x == 0) {
#define X(i, name) { const unsigned long long v_ = (unsigned long long)a0.name; argv[2 * i] = (unsigned)v_; argv[2 * i + 1] = (unsigned)(v_ >> 32); }
        ARG_LIST(X)
#undef X
    }
    if (threadIdx.x == 0) { volatile LAS unsigned* st_ = (volatile LAS unsigned*)(unsigned)(ARGV_OFF + 512); st_[0] = 0u; st_[1] = 0u; }
    __syncthreads();
    (void)xcd_barrier_post((unsigned*)(a0.ws + WS_BAR), (volatile LAS unsigned*)(unsigned)(ARGV_OFF + 512));
    Frame F; F.lds = lds;
    PG8_LAS unsigned char* lds3 = (PG8_LAS unsigned char*)lds;
#define GSYNC_CG() do { asm volatile("s_waitcnt vmcnt(0) lgkmcnt(0)" ::: "memory"); __syncthreads(); if (threadIdx.x == 0) { asm volatile("buffer_wbl2 sc1\n\ts_waitcnt vmcnt(0)" ::: "memory"); } grid.sync(); asm volatile("buffer_inv sc1\n\ts_waitcnt vmcnt(0)" ::: "memory"); } while (0)
#define GSYNC() do { XcdBarrier b_; b_.bar = (unsigned*)(ldarg<unsigned char>(argv, 20) + WS_BAR); b_.x = xb_xcc_id(); b_.st = (volatile LAS unsigned*)(unsigned)(ARGV_OFF + 512); xcd_barrier(b_); } while (0)
#define PHASE_BEGIN() int t_ = threadIdx.x; asm volatile("" : "+v"(t_)); F.tid = t_; F.lane = t_ & 63; F.wave = __builtin_amdgcn_readfirstlane(t_ >> 6); \
    int G_ = gridDim.x, bx_ = blockIdx.x; asm volatile("" : "+s"(G_), "+s"(bx_)); F.G = G_; F.vcu = (G_ % 8 == 0) ? (bx_ % 8) * (G_ / 8) + bx_ / 8 : bx_; \
    unsigned ab_ = ARGV_OFF; asm volatile("" : "+v"(ab_)); const Args a = load_args((lds_vu32*)ab_); unsigned char* ws = a.ws; float* ADA = (float*)(ws + WS_ADA); bf16* U = (bf16*)(ws + WS_U); bf16* Y = (bf16*)(ws + WS_Y); bf16* R1 = (bf16*)(ws + WS_R1); \
    (void)ADA; (void)U; (void)Y; (void)R1
#ifndef ONLY
#define ON(k) 1
#else
#define ON(k) ((ONLY>>(k))&1)
#endif
    if (ON(0)) { PHASE_BEGIN(); phase_ada(F, a); }
    GSYNC_CG();
    if (ON(1)) { PHASE_BEGIN(); phase_ln(F, a, a.x, nullptr, nullptr, nullptr, ADA + 0 * D, ADA + 1 * D, U, 0); }
    GSYNC();
#if defined(PROBE) && PROBE == 12
    { PHASE_BEGIN(); const bf16* wsrc = (const bf16*)(ws + WS_WINA); const size_t gt = (size_t)blockIdx.x * 512 + threadIdx.x, GT = (size_t)gridDim.x * 512;
      for (size_t i = gt; i < (size_t)T * D; i += GT) a.out[i] = __uint_as_float(((unsigned)wsrc[i % (size_t)(33 * 512 * 1024)]) << 16); return; }
#endif
#if defined(PROBE) && PROBE == 1
    { PHASE_BEGIN(); probe_dump(a.out, U, 1024, (const float*)(ws + WS_ADA), 4 * 4 * 6144); return; }
#endif
    for (int l = 0; l < DEPTH; ++l) {
        if (ON(2)) { PHASE_BEGIN(); pg8::Gemm g{U, (bf16*)(ws + WS_WINA), T, NA, D}; pg8::StaticOrder S; S.init(T, NA, F.G, bx_);
          pg8::EpiAct<0> E{R1, NA, a.b_in + (size_t)l * INW, 0, 0, 4, 7, attn_body::C2};
          pg8::gemm_phase<pg8::EpiAct<0>, pg8::StaticOrder, true, true>(lds3, g, S, E); }
        GSYNC();
#if defined(PROBE) && PROBE == 2
        { PHASE_BEGIN(); probe_dump(a.out, R1, NA, (const float*)(ws + WS_LOGF), 16 * SEQ); return; }
#endif
        if (ON(3)) { PHASE_BEGIN(); phase_prep(F, a, l); }
        GSYNC();
#if defined(PROBE) && PROBE == 3
        { PHASE_BEGIN(); probe_dump(a.out, R1, NA, (const float*)(ws + WS_KBIAS), 16 * SEQ + 32768 * 0); return; }
#endif
#if defined(PROBE) && PROBE == 31
        { PHASE_BEGIN(); probe_dump(a.out, Y, 512, (const float*)(ws + WS_KBAR), 32768); return; }
#endif
        if (ON(4)) { PHASE_BEGIN(); const attn_body::AttnTensors AT{(const attn_body::bf16*)R1, (attn_body::bf16*)Y, (const float*)(ws + WS_KBIAS), (const float*)(ws + WS_KBAR), (const float*)(ws + WS_NRM)};
          attn_body::attn_phase<24>((char*)lds, AT, F.vcu, F.G); }
        GSYNC();
#if defined(PROBE) && PROBE == 4
        { PHASE_BEGIN(); probe_dump(a.out, Y + (size_t)2 * T * 256, 512, nullptr, 1); return; }
#endif
        if (ON(5)) { PHASE_BEGIN(); pg8::Gemm g{U, (bf16*)(ws + WS_WG), T, NG, D}; pg8::StaticOrder S; S.init(T, NG, F.G, bx_);
          pg8::EpiGate8 E{ws + WS_R1, a.b_in + (size_t)l * INW + GCOL, 1.0f};
          pg8::gemm_phase<pg8::EpiGate8, pg8::StaticOrder, true, true>(lds3, g, S, E); }
        GSYNC();
#if defined(PROBE) && PROBE == 5
        { PHASE_BEGIN(); probe_dump(a.out, R1, 4096, nullptr, 1); return; }
#endif
        if (ON(6)) { PHASE_BEGIN(); phase_merge(F, Y, (const bf16*)(ws + WS_WB), ws + WS_R1, U); }
        GSYNC();
#if defined(PROBE) && PROBE == 6
        { PHASE_BEGIN(); probe_dump(a.out, R1, 1024, nullptr, 1); return; }
#endif
        if (ON(7)) { PHASE_BEGIN(); pg8::Gemm g{U, (bf16*)(ws + WS_WO), T, D, D}; pg8::StaticOrder S; S.init(T, D, F.G, bx_);
          if (l == 0) { pg8::EpiRes<true> E{a.x, (bf16*)(ws + WS_YB), ADA + 2 * D, nullptr}; pg8::gemm_phase<pg8::EpiRes<true>, pg8::StaticOrder, true, true>(lds3, g, S, E); }
          else { pg8::EpiRes<false> E{ws + WS_YB, (bf16*)(ws + WS_YB), ADA + (size_t)l * BATCH * 6 * D + 2 * D, (const float*)(ws + WS_STATS)}; pg8::gemm_phase<pg8::EpiRes<false>, pg8::StaticOrder, true, true>(lds3, g, S, E); } }
        GSYNC();
#if defined(PROBE) && PROBE == 7
        return;
#endif
        if (ON(8)) { PHASE_BEGIN(); const float* ada_l = ADA + (size_t)l * BATCH * 6 * D; phase_ln(F, a, nullptr, nullptr, a.ln1_g + l * D, a.ln1_b + l * D, ada_l + 3 * D, ada_l + 4 * D, U, -1, (float*)(ws + WS_STATS), (const bf16*)(ws + WS_YB)); }
        GSYNC();
#if defined(PROBE) && PROBE == 8
        return;
#endif
        if (ON(9)) { PHASE_BEGIN(); pg8::Gemm g{U, (bf16*)(ws + WS_WUP), T, FF, D}; pg8::StaticOrder S; S.init(T, FF, F.G, bx_);
          pg8::EpiAct<2> E{R1, FF, a.b_up + (size_t)l * FF, 0, 0, -1, -1, 1.f};
          pg8::gemm_phase<pg8::EpiAct<2>, pg8::StaticOrder, true, true>(lds3, g, S, E); }
        GSYNC();
#if defined(PROBE) && PROBE == 9
        { PHASE_BEGIN(); probe_dump(a.out, R1, 4096, nullptr, 1); return; }
#endif
        if (ON(10)) { PHASE_BEGIN(); pg8::Gemm g{R1, (bf16*)(ws + WS_WDN), T, D, FF}; pg8::StaticOrder S; S.init(T, D, F.G, bx_);
          pg8::EpiRes<false> E{ws + WS_YB, (bf16*)(ws + WS_YB), ADA + (size_t)l * BATCH * 6 * D + 5 * D, (const float*)(ws + WS_STATS)};
          pg8::gemm_phase<pg8::EpiRes<false>, pg8::StaticOrder, true, true>(lds3, g, S, E); }
        GSYNC();
#if defined(PROBE) && PROBE == 10
        return;
#endif
        if (ON(11)) { PHASE_BEGIN();
            if (l + 1 < DEPTH) { const float* ada_n = ADA + (size_t)(l + 1) * BATCH * 6 * D;
                phase_ln(F, a, nullptr, nullptr, a.ln2_g + l * D, a.ln2_b + l * D, ada_n + 0 * D, ada_n + 1 * D, U, l + 1, (float*)(ws + WS_STATS), (const bf16*)(ws + WS_YB));
                convert_weights(F, a, l + 1); }
            else phase_ln(F, a, nullptr, a.out, a.ln2_g + l * D, a.ln2_b + l * D, nullptr, nullptr, nullptr, -1, nullptr, (const bf16*)(ws + WS_YB)); }
        if (l + 1 < DEPTH) GSYNC();
    }
}
extern "C" void kernel_launch(void* const* d_in, const int* in_sizes, int n_in, void* d_out, int out_size, void* d_ws, size_t ws_size, hipStream_t stream) {
    static int grid = 0;
    if (grid == 0) {
        if (n_in != 19 || out_size != T * D || ws_size < WS_END) { fprintf(stderr, "kernel_launch: unexpected shapes: n_in %d out %d ws %zu\n", n_in, out_size, ws_size); grid = -1; return; }
        int dev = 0, cus = 0, per_cu = 0;
        (void)hipGetDevice(&dev); (void)hipDeviceGetAttribute(&cus, hipDeviceAttributeMultiprocessorCount, dev);
        (void)hipFuncSetAttribute((const void*)fwd_megakernel, hipFuncAttributeMaxDynamicSharedMemorySize, LDS_BYTES);
        (void)hipOccupancyMaxActiveBlocksPerMultiprocessor(&per_cu, (const void*)fwd_megakernel, NWAVES * 64, LDS_BYTES);
        if (per_cu < 1) per_cu = 1;
        grid = cus * per_cu; if (grid > 256) grid = 256;
        fprintf(stderr, "kernel_launch: grid %d (cus %d, per_cu %d), ws %zu\n", grid, cus, per_cu, ws_size);
    }
    if (grid < 0) return;
    Args a{};
    a.x = (const float*)d_in[0]; a.c = (const float*)d_in[1]; a.pos = (const int*)d_in[2]; a.w_ada = (const float*)d_in[3]; a.b_ada = (const float*)d_in[4];
    a.w_in = (const float*)d_in[5]; a.b_in = (const float*)d_in[6]; a.w_pool = (const float*)d_in[7]; a.pool_scale = (const float*)d_in[8]; a.conv_w = (const float*)d_in[9];
    a.w_branch = (const float*)d_in[10]; a.w_o = (const float*)d_in[11]; a.ln1_g = (const float*)d_in[12]; a.ln1_b = (const float*)d_in[13]; a.w_up = (const float*)d_in[14];
    a.b_up = (const float*)d_in[15]; a.w_down = (const float*)d_in[16]; a.ln2_g = (const float*)d_in[17]; a.ln2_b = (const float*)d_in[18];
    a.out = (float*)d_out; a.ws = (unsigned char*)d_ws;
    (void)hipMemsetAsync((unsigned char*)d_ws + WS_BAR, 0, BAR_ZERO_BYTES, stream);
    void* args[] = {&a};
    const hipError_t e = hipLaunchCooperativeKernel((void*)fwd_megakernel, dim3(grid), dim3(NWAVES * 64), args, LDS_BYTES, stream);
    if (e != hipSuccess) fprintf(stderr, "kernel_launch: cooperative launch failed: %s (grid %d)\n", hipGetErrorString(e), grid);
}
```
